# Optimizing an MI355X kernel written in HIP

```python
import jax, jax.numpy as jnp
from jax import lax
import numpy as np

D_MODEL = 1024
BATCH = 16
SEQ = 2048
DEPTH = 2

HEAD_DIM = 64
N_ATTN_HEADS = D_MODEL // (2 * HEAD_DIM)
N_GMLP_GROUPS = D_MODEL // (2 * HEAD_DIM)
ATTN_WIDTH = N_ATTN_HEADS * HEAD_DIM
GMLP_WIDTH = N_GMLP_GROUPS * HEAD_DIM
MIX_WIDTH = ATTN_WIDTH + GMLP_WIDTH
IN_PROJ_WIDTH = 3 * ATTN_WIDTH + 2 * GMLP_WIDTH
MOBA_BLOCK = 256
MOBA_TOP_K = 3
QUERY_CHUNK = 16
GMLP_CHUNK = 128
D_FF = ((8 * D_MODEL // 3 + 255) // 256) * 256
PLE_DIM = 256
RMS_EPS = 1e-6
LN_EPS = 1e-5
NEG_INF = -1e30

kernel_name = "hybrid_moba_gmlp_macaron_trunk"


def rms_norm(x, g):
    xf = x.astype(jnp.float32)
    y = xf * lax.rsqrt(jnp.mean(xf * xf, axis=-1, keepdims=True) + RMS_EPS)
    return (y * g.astype(jnp.float32)).astype(x.dtype)


def swiglu_ffn(x, w_gate, w_up, w_down):
    return (jax.nn.silu(x @ w_gate) * (x @ w_up)) @ w_down


def alibi_slopes(n_heads):
    start = 2.0 ** (-8.0 / n_heads)
    return jnp.asarray(np.array([start ** (i + 1) for i in range(n_heads)], dtype=np.float32))


def moba_attention(q, k, v):
    B, H, S, dh = q.shape
    nb = -(-S // MOBA_BLOCK)
    pad = nb * MOBA_BLOCK - S
    padding = ((0, 0), (0, 0), (0, pad), (0, 0))
    k_blocks = jnp.pad(k, padding).reshape(B, H, nb, MOBA_BLOCK, dh)
    v_blocks = jnp.pad(v, padding).reshape(B, H, nb, MOBA_BLOCK, dh)
    slopes = alibi_slopes(H)
    scale = dh ** -0.5

    k_mean = jnp.mean(k_blocks.astype(jnp.float32), axis=3)
    gate = jnp.einsum("bhsd,bhnd->bhsn", q.astype(jnp.float32), k_mean)
    pos = jnp.arange(S)
    fully_past = jnp.arange(nb)[None, :] < (pos // MOBA_BLOCK)[:, None]
    gate = jnp.where(fully_past[None, None], gate, NEG_INF)
    n_sel = min(MOBA_TOP_K, nb)
    top_vals, top_idx = lax.top_k(gate, n_sel)
    sel_valid = top_vals > 0.5 * NEG_INF

    nqc = S // QUERY_CHUNK

    def to_chunks(a):
        a = a.reshape((B, H, nqc, QUERY_CHUNK) + a.shape[3:])
        return jnp.moveaxis(a, 2, 0)

    b_ix = jnp.arange(B)[:, None, None, None]
    h_ix = jnp.arange(H)[None, :, None, None]
    blk_off = jnp.arange(MOBA_BLOCK)
    n_sel_keys = n_sel * MOBA_BLOCK

    def one_chunk(args):
        q_c, idx_c, valid_c, c = args
        t = c * QUERY_CHUNK + jnp.arange(QUERY_CHUNK)
        own = (c * QUERY_CHUNK) // MOBA_BLOCK
        k_own = lax.dynamic_index_in_dim(k_blocks, own, axis=2, keepdims=False)
        v_own = lax.dynamic_index_in_dim(v_blocks, own, axis=2, keepdims=False)
        s_own = own * MOBA_BLOCK + blk_off
        l_own = jnp.einsum("bhqd,bhkd->bhqk", q_c, k_own).astype(jnp.float32) * scale
        d_own = (t[:, None] - s_own[None, :]).astype(jnp.float32)
        l_own = l_own - slopes[None, :, None, None] * d_own[None, None]
        l_own = jnp.where((s_own[None, :] <= t[:, None])[None, None], l_own, NEG_INF)
        k_sel = k_blocks[b_ix, h_ix, idx_c]
        v_sel = v_blocks[b_ix, h_ix, idx_c]
        l_sel = jnp.einsum("bhqd,bhqnkd->bhqnk", q_c, k_sel).astype(jnp.float32) * scale
        s_sel = idx_c[..., None] * MOBA_BLOCK + blk_off
        d_sel = (t[None, None, :, None, None] - s_sel).astype(jnp.float32)
        l_sel = l_sel - slopes[None, :, None, None, None] * d_sel
        l_sel = jnp.where(valid_c[..., None], l_sel, NEG_INF)
        logits = jnp.concatenate([l_sel.reshape(B, H, QUERY_CHUNK, n_sel_keys), l_own], axis=-1)
        probs = jax.nn.softmax(logits, axis=-1).astype(v.dtype)
        p_sel = probs[..., :n_sel_keys].reshape(B, H, QUERY_CHUNK, n_sel, MOBA_BLOCK)
        p_own = probs[..., n_sel_keys:]
        return (jnp.einsum("bhqnk,bhqnkd->bhqd", p_sel, v_sel)
                + jnp.einsum("bhqk,bhkd->bhqd", p_own, v_own))

    out = lax.map(one_chunk, (to_chunks(q), to_chunks(top_idx), to_chunks(sel_valid),
                              jnp.arange(nqc)))
    return jnp.moveaxis(out, 0, 2).reshape(B, H, S, dh)


def chunked_spatial_gating(u, v, ln_g, ln_b, w_s, b_s):
    B, S, G, dg = v.shape
    vf = v.astype(jnp.float32)
    mu = jnp.mean(vf, axis=-1, keepdims=True)
    var = jnp.mean(jnp.square(vf - mu), axis=-1, keepdims=True)
    vn = ((vf - mu) * lax.rsqrt(var + LN_EPS) * ln_g.reshape(G, dg).astype(jnp.float32)
          + ln_b.reshape(G, dg).astype(jnp.float32)).astype(v.dtype)
    nc = S // GMLP_CHUNK
    causal = jnp.tril(jnp.ones((GMLP_CHUNK, GMLP_CHUNK), dtype=w_s.dtype))
    mixed = jnp.einsum("gts,bcsgd->bctgd", w_s * causal,
                       vn.reshape(B, nc, GMLP_CHUNK, G, dg))
    mixed = mixed + b_s.T[None, None, :, :, None]
    return u * mixed.reshape(B, S, G, dg)


def token_mixer(hn, w_in, gmlp_ln_g, gmlp_ln_b, gmlp_w_s, gmlp_b_s,
                attn_out_norm, gmlp_out_norm, w_out):
    B, S, _ = hn.shape
    z = hn @ w_in
    q, k, v, gu, gv = jnp.split(
        z, [ATTN_WIDTH, 2 * ATTN_WIDTH, 3 * ATTN_WIDTH, 3 * ATTN_WIDTH + GMLP_WIDTH], axis=-1)

    def heads(a):
        return a.reshape(B, S, N_ATTN_HEADS, HEAD_DIM).transpose(0, 2, 1, 3)

    attn = moba_attention(heads(q), heads(k), heads(v))
    attn = attn.transpose(0, 2, 1, 3).reshape(B, S, ATTN_WIDTH)

    gu = jax.nn.gelu(gu, approximate=False).reshape(B, S, N_GMLP_GROUPS, HEAD_DIM)
    gv = jax.nn.gelu(gv, approximate=False).reshape(B, S, N_GMLP_GROUPS, HEAD_DIM)
    g = chunked_spatial_gating(gu, gv, gmlp_ln_g, gmlp_ln_b, gmlp_w_s, gmlp_b_s)
    g = g.reshape(B, S, GMLP_WIDTH)

    merged = jnp.concatenate([rms_norm(attn, attn_out_norm), rms_norm(g, gmlp_out_norm)], axis=-1)
    return merged @ w_out


def setup_inputs(seed: int = 0) -> dict:
    key = jax.random.key(seed)
    ks = iter(jax.random.split(key, 32))

    def nrm(shape, scale):
        return jax.random.normal(next(ks), shape, jnp.float32) * scale

    def gain(n):
        return 1.0 + nrm((DEPTH, n), 0.05)

    return {
        "x": nrm((BATCH, SEQ, D_MODEL), 1.0),
        "p": nrm((DEPTH, BATCH, SEQ, PLE_DIM), 1.0),
        "ffn1_pre_norm": gain(D_MODEL),
        "ffn1_w_gate": nrm((DEPTH, D_MODEL, D_FF), D_MODEL ** -0.5),
        "ffn1_w_up": nrm((DEPTH, D_MODEL, D_FF), D_MODEL ** -0.5),
        "ffn1_w_down": nrm((DEPTH, D_FF, D_MODEL), D_FF ** -0.5),
        "ffn1_post_norm": gain(D_MODEL),
        "mix_pre_norm": gain(D_MODEL),
        "w_in": nrm((DEPTH, D_MODEL, IN_PROJ_WIDTH), D_MODEL ** -0.5),
        "gmlp_ln_g": gain(GMLP_WIDTH),
        "gmlp_ln_b": nrm((DEPTH, GMLP_WIDTH), 0.02),
        "gmlp_w_s": nrm((DEPTH, N_GMLP_GROUPS, GMLP_CHUNK, GMLP_CHUNK), GMLP_CHUNK ** -0.5),
        "gmlp_b_s": 1.0 + nrm((DEPTH, N_GMLP_GROUPS, GMLP_CHUNK), 0.1),
        "attn_out_norm": gain(ATTN_WIDTH),
        "gmlp_out_norm": gain(GMLP_WIDTH),
        "w_out": nrm((DEPTH, MIX_WIDTH, D_MODEL), MIX_WIDTH ** -0.5),
        "mix_post_norm": gain(D_MODEL),
        "ffn2_pre_norm": gain(D_MODEL),
        "ffn2_w_gate": nrm((DEPTH, D_MODEL, D_FF), D_MODEL ** -0.5),
        "ffn2_w_up": nrm((DEPTH, D_MODEL, D_FF), D_MODEL ** -0.5),
        "ffn2_w_down": nrm((DEPTH, D_FF, D_MODEL), D_FF ** -0.5),
        "ffn2_post_norm": gain(D_MODEL),
        "ple_pre_norm": gain(D_MODEL),
        "ple_w_gate": nrm((DEPTH, D_MODEL, D_MODEL), D_MODEL ** -0.5),
        "ple_w_proj": nrm((DEPTH, PLE_DIM, D_MODEL), PLE_DIM ** -0.5),
        "ple_post_norm": gain(D_MODEL),
    }


def reference(x, p,
              ffn1_pre_norm, ffn1_w_gate, ffn1_w_up, ffn1_w_down, ffn1_post_norm,
              mix_pre_norm, w_in, gmlp_ln_g, gmlp_ln_b, gmlp_w_s, gmlp_b_s,
              attn_out_norm, gmlp_out_norm, w_out, mix_post_norm,
              ffn2_pre_norm, ffn2_w_gate, ffn2_w_up, ffn2_w_down, ffn2_post_norm,
              ple_pre_norm, ple_w_gate, ple_w_proj, ple_post_norm):
    h = x
    for i in range(DEPTH):
        f1 = swiglu_ffn(rms_norm(h, ffn1_pre_norm[i]), ffn1_w_gate[i], ffn1_w_up[i], ffn1_w_down[i])
        h = h + 0.5 * rms_norm(f1, ffn1_post_norm[i])
        m = token_mixer(rms_norm(h, mix_pre_norm[i]), w_in[i], gmlp_ln_g[i], gmlp_ln_b[i],
                        gmlp_w_s[i], gmlp_b_s[i], attn_out_norm[i], gmlp_out_norm[i], w_out[i])
        h = h + rms_norm(m, mix_post_norm[i])
        f2 = swiglu_ffn(rms_norm(h, ffn2_pre_norm[i]), ffn2_w_gate[i], ffn2_w_up[i], ffn2_w_down[i])
        h = h + 0.5 * rms_norm(f2, ffn2_post_norm[i])
        gate = jax.nn.sigmoid(rms_norm(h, ple_pre_norm[i]) @ ple_w_gate[i])
        e = gate * (p[i] @ ple_w_proj[i])
        h = h + rms_norm(e, ple_post_norm[i])
    return h
```

```cpp
#include <hip/hip_runtime.h>
#include <cstdio>
#include <cstdint>
#include <cmath>
namespace pg8 {
#define PG8_LAS __attribute__((address_space(3)))
typedef unsigned short bf16_t;
typedef short bf16x8 __attribute__((ext_vector_type(8)));
typedef float f32x4 __attribute__((ext_vector_type(4)));
typedef unsigned u32x4 __attribute__((ext_vector_type(4)));
constexpr int BM = 256, BK = 64, HALF = 128, HTB = HALF * BK * 2  , STAGE_BYTES = 8 * HTB, NXCD = 8, WGM = 8;

__host__ __device__ __forceinline__ int lds_byte(int r, int c) { const int st = (r >> 4) * 2 + (c >> 5), rr = r & 15, cc = c & 31, ob = rr * 64 + cc * 2; return st * 1024 + (ob ^ (((ob >> 9) & 1) << 5)); }
__host__ __device__ __forceinline__ void stage_rc(int b, int& R, int& C) { const int st = b / 1024, sb = b % 1024, swz = sb ^ (((sb >> 9) & 1) << 5); R = (st >> 1) * 16 + swz / 64; C = (st & 1) * 32 + (swz % 64) / 2; }
__host__ __device__ __forceinline__ int perm32(int rho) { const int n = rho >> 4, i = rho & 15; return 8 * (i >> 2) + 4 * n + (i & 3); }

struct Unit { int pm, pn; };
struct Gemm { const bf16_t* A; const bf16_t* Bt; int M, N, K; };

struct StaticOrder {
    int nM, nN, nwg, G, c;
    __host__ __device__ void init(int M, int N, int G_, int c_) { nM = M / BM; nN = N / BM; nwg = nM * nN; G = G_; c = c_; }
    __host__ __device__ bool next(int i, Unit& u) const {
        const long L = (long)i * G + c; if (L >= nwg) return false;
        int wgid = (int)L; { const int q = nwg / NXCD, r = nwg % NXCD, xcd = wgid % NXCD, off = wgid / NXCD; wgid = (xcd < r ? xcd * (q + 1) : r * (q + 1) + (xcd - r) * q) + off; }
        const int nig = WGM * nN, gid = wgid / nig, fm = gid * WGM, gsz = (nM - fm) < WGM ? (nM - fm) : WGM;
        u.pm = fm + ((wgid % nig) % gsz); u.pn = (wgid % nig) / gsz; return true;
    }
    __device__ __forceinline__ void a_ready(const Unit&) const {}
    __device__ __forceinline__ void done(const Unit&) const {}
};

__device__ __forceinline__ unsigned cvt_pk_bf16(float lo, float hi) { unsigned r; asm volatile("v_cvt_pk_bf16_f32 %0, %1, %2" : "=v"(r) : "v"(lo), "v"(hi)); return r; }
typedef float f32x2 __attribute__((ext_vector_type(2)));
__device__ __forceinline__ f32x2 gelu_pk(f32x2 v) {
    const f32x2 av = __builtin_elementwise_abs(v), d = av * 0.2316418882f + 1.0f;
    f32x2 t; t.x = __builtin_amdgcn_rcpf(d.x); t.y = __builtin_amdgcn_rcpf(d.y);
    f32x2 q = t * 0.5307027145f + (-0.7265760135f); q = q * t + 0.7107068705f; q = q * t + (-0.142248368f); q = q * t + 0.127414796f; q = q * t;
    const f32x2 s = (v * v) * (-0.72134752044f);
    f32x2 e; e.x = __builtin_amdgcn_exp2f(s.x); e.y = __builtin_amdgcn_exp2f(s.y);
    const f32x2 m = v * (q * e), r = v - m;
    f32x2 o; o.x = v.x < 0.f ? m.x : r.x; o.y = v.y < 0.f ? m.y : r.y; return o;
}

template <int ACT  > struct EpiBf16 {
    static constexpr bool PERM = true, AFTER_DRAIN = false; static_assert(ACT == 0 || ACT == 1, "EpiBf16: ACT is 0 (none) or 1 (gelu_pk)");
    bf16_t* O; int ldc; const float* bias; int split_cols; size_t split_stride; float scale0;
    __device__ __forceinline__ void operator()(const f32x4 (&acc)[2][2][4][2], const Unit& u, int wr, int wc, int fr, int fq) const {
        const int row0 = u.pm * BM + wr * 64 + fr; int colt = u.pn * BM; bf16_t* base = O;
        float sc = 1.f; if (split_cols) { const int t = colt / split_cols; base += (size_t)t * split_stride; colt -= t * split_cols; if (t == 0) sc = scale0; }
        const int col0 = colt + wc * 32 + 8 * fq, bcol0 = u.pn * BM + wc * 32 + 8 * fq;
        f32x4 bv[2][2];
#pragma unroll
        for (int bj = 0; bj < 2; ++bj)
#pragma unroll
            for (int n = 0; n < 2; ++n) bv[bj][n] = bias ? *(const f32x4*)(bias + bcol0 + bj * HALF + 4 * n) : (f32x4){0.f, 0.f, 0.f, 0.f};
#pragma unroll
        for (int ai = 0; ai < 2; ++ai)
#pragma unroll
            for (int m = 0; m < 4; ++m) { bf16_t* rowp = base + (size_t)(row0 + ai * HALF + m * 16) * ldc + col0;
#pragma unroll
                for (int bj = 0; bj < 2; ++bj) { f32x4 v0 = acc[ai][bj][m][0] + bv[bj][0], v1 = acc[ai][bj][m][1] + bv[bj][1];
                    if (ACT == 1) { f32x2 a = gelu_pk((f32x2){v0[0], v0[1]}), b = gelu_pk((f32x2){v0[2], v0[3]}), c = gelu_pk((f32x2){v1[0], v1[1]}), d = gelu_pk((f32x2){v1[2], v1[3]});
                        v0 = (f32x4){a.x, a.y, b.x, b.y}; v1 = (f32x4){c.x, c.y, d.x, d.y}; }
                    v0 = v0 * sc; v1 = v1 * sc; u32x4 w; w.x = cvt_pk_bf16(v0[0], v0[1]); w.y = cvt_pk_bf16(v0[2], v0[3]); w.z = cvt_pk_bf16(v1[0], v1[1]); w.w = cvt_pk_bf16(v1[2], v1[3]);
                    *(u32x4*)(rowp + bj * HALF) = w; } }
    }
};
__device__ __forceinline__ float fast_sigmoid(float x) { return __builtin_amdgcn_rcpf(1.0f + __builtin_amdgcn_exp2f(x * -1.4426950408889634f)); }
struct EpiSwiGLU {
    static constexpr bool PERM = true, AFTER_DRAIN = false;
    bf16_t* O; int ldc;
    __device__ __forceinline__ void operator()(const f32x4 (&acc)[2][2][4][2], const Unit& u, int wr, int wc, int fr, int fq) const {
        const int row0 = u.pm * BM + wr * 64 + fr, col0 = u.pn * HALF + wc * 32 + 8 * fq;
#pragma unroll
        for (int ai = 0; ai < 2; ++ai)
#pragma unroll
            for (int m = 0; m < 4; ++m) { bf16_t* rowp = O + (size_t)(row0 + ai * HALF + m * 16) * ldc + col0;
                float o[8];
#pragma unroll
                for (int n = 0; n < 2; ++n)
#pragma unroll
                    for (int i = 0; i < 4; ++i) { const float g = acc[ai][0][m][n][i], up = acc[ai][1][m][n][i]; o[n * 4 + i] = g * fast_sigmoid(g) * up; }
                u32x4 w; w.x = cvt_pk_bf16(o[0], o[1]); w.y = cvt_pk_bf16(o[2], o[3]); w.z = cvt_pk_bf16(o[4], o[5]); w.w = cvt_pk_bf16(o[6], o[7]);
                *(u32x4*)rowp = w; }
    }
};
struct EpiInProj {
    static constexpr bool PERM = true, AFTER_DRAIN = false;
    bf16_t* Z; size_t zstride; float qscale;
    __device__ __forceinline__ void operator()(const f32x4 (&acc)[2][2][4][2], const Unit& u, int wr, int wc, int fr, int fq) const {
        const int t = u.pn >> 1; const int row0 = u.pm * BM + wr * 64 + fr, col0 = (u.pn & 1) * BM + wc * 32 + 8 * fq;
        bf16_t* base = Z + (size_t)t * zstride; const float sc = (t == 0) ? qscale : 1.0f; const bool act = (t >= 3);
#pragma unroll
        for (int ai = 0; ai < 2; ++ai)
#pragma unroll
            for (int m = 0; m < 4; ++m) { bf16_t* rowp = base + (size_t)(row0 + ai * HALF + m * 16) * 512 + col0;
#pragma unroll
                for (int bj = 0; bj < 2; ++bj) { f32x4 v0 = acc[ai][bj][m][0], v1 = acc[ai][bj][m][1];
                    if (act) { f32x2 a = gelu_pk((f32x2){v0[0], v0[1]}), b = gelu_pk((f32x2){v0[2], v0[3]}), c = gelu_pk((f32x2){v1[0], v1[1]}), d = gelu_pk((f32x2){v1[2], v1[3]});
                        v0 = (f32x4){a.x, a.y, b.x, b.y}; v1 = (f32x4){c.x, c.y, d.x, d.y}; }
                    v0 = v0 * sc; v1 = v1 * sc; u32x4 w; w.x = cvt_pk_bf16(v0[0], v0[1]); w.y = cvt_pk_bf16(v0[2], v0[3]); w.z = cvt_pk_bf16(v1[0], v1[1]); w.w = cvt_pk_bf16(v1[2], v1[3]);
                    *(u32x4*)(rowp + bj * HALF) = w; } }
    }
};
struct EpiPleGate {
    static constexpr bool PERM = true, AFTER_DRAIN = false;
    bf16_t* O; const bf16_t* E0; int ldc;
    __device__ __forceinline__ void operator()(const f32x4 (&acc)[2][2][4][2], const Unit& u, int wr, int wc, int fr, int fq) const {
        const int row0 = u.pm * BM + wr * 64 + fr, col0 = u.pn * BM + wc * 32 + 8 * fq;
#pragma unroll
        for (int ai = 0; ai < 2; ++ai)
#pragma unroll
            for (int m = 0; m < 4; ++m) { const size_t off = (size_t)(row0 + ai * HALF + m * 16) * ldc + col0;
#pragma unroll
                for (int bj = 0; bj < 2; ++bj) { const u32x4 e = *(const u32x4*)(E0 + off + bj * HALF); const f32x4 v0 = acc[ai][bj][m][0], v1 = acc[ai][bj][m][1];
                    float o[8];
                    o[0] = fast_sigmoid(v0[0]) * __uint_as_float(e.x << 16); o[1] = fast_sigmoid(v0[1]) * __uint_as_float(e.x & 0xffff0000u);
                    o[2] = fast_sigmoid(v0[2]) * __uint_as_float(e.y << 16); o[3] = fast_sigmoid(v0[3]) * __uint_as_float(e.y & 0xffff0000u);
                    o[4] = fast_sigmoid(v1[0]) * __uint_as_float(e.z << 16); o[5] = fast_sigmoid(v1[1]) * __uint_as_float(e.z & 0xffff0000u);
                    o[6] = fast_sigmoid(v1[2]) * __uint_as_float(e.w << 16); o[7] = fast_sigmoid(v1[3]) * __uint_as_float(e.w & 0xffff0000u);
                    u32x4 w; w.x = cvt_pk_bf16(o[0], o[1]); w.y = cvt_pk_bf16(o[2], o[3]); w.z = cvt_pk_bf16(o[4], o[5]); w.w = cvt_pk_bf16(o[6], o[7]);
                    *(u32x4*)(O + off + bj * HALF) = w; } }
    }
};
template <class Epi, class Sched, bool ALIGN_EPI = false, bool SP2 = false>
__device__ __forceinline__ void gemm_phase(PG8_LAS unsigned char* lds, const Gemm g, const Sched& S, const Epi& E) {
    const int tid = threadIdx.x, wid = __builtin_amdgcn_readfirstlane(tid >> 6), lane = tid & 63, wr = wid >> 2, wc = wid & 3, fr = lane & 15, fq = lane >> 4;
    const int K = g.K, nt = K / BK;
    unsigned voffA[2], voffB[2];
#pragma unroll
    for (int i = 0; i < 2; ++i) { int R, C; stage_rc(tid * 16 + i * 8192, R, C); const int Rb = Epi::PERM ? ((R & ~31) + perm32(R & 31)) : R;
        voffA[i] = (unsigned)(R * K + C) * 2u; voffB[i] = (unsigned)(Rb * K + C) * 2u; }
    const size_t kstep = (size_t)(BK * 2);
    const size_t hstep = (size_t)HALF * K * 2;
    const size_t tstep = 2 * hstep;
    const unsigned ldsw = (unsigned)wid * 1024u;
    const int aoff = lds_byte(wr * 64 + fr, fq * 8), boff = lds_byte(wc * 32 + fr, fq * 8);
#define PG8_SA(b, h) (((b) * 2 + (h)) * HTB)
#define PG8_SB(b, h) ((4 + (b) * 2 + (h)) * HTB)
#define PG8_STAGE(bufoff, gbase, voff) do { _Pragma("unroll") for (int _i = 0; _i < 2; ++_i) \
        __builtin_amdgcn_global_load_lds((const unsigned*)((const char*)(gbase) + (voff)[_i]), (PG8_LAS unsigned*)(lds + (bufoff) + ldsw + _i * 8192), 16, 0, 0); } while (0)
#define PG8_LDA(dst, b, h) do { _Pragma("unroll") for (int m = 0; m < 4; ++m) _Pragma("unroll") for (int k = 0; k < 2; ++k) dst[m][k] = *(const PG8_LAS bf16x8*)(lds + PG8_SA(b, h) + aoff + m * 2048 + k * 1024); } while (0)
#define PG8_LDB(dst, b, h) do { _Pragma("unroll") for (int n = 0; n < 2; ++n) _Pragma("unroll") for (int k = 0; k < 2; ++k) dst[n][k] = *(const PG8_LAS bf16x8*)(lds + PG8_SB(b, h) + boff + n * 2048 + k * 1024); } while (0)
#define PG8_MMA(ai, bj, At, Bt) do { __builtin_amdgcn_s_setprio(1); _Pragma("unroll") for (int m = 0; m < 4; ++m) _Pragma("unroll") for (int n = 0; n < 2; ++n) _Pragma("unroll") for (int k = 0; k < 2; ++k) \
        acc[ai][bj][m][n] = __builtin_amdgcn_mfma_f32_16x16x32_bf16(Bt[n][k], At[m][k], acc[ai][bj][m][n], 0, 0, 0); __builtin_amdgcn_s_setprio(0); } while (0)
#define PG8_WAIT_V(n) asm volatile("s_waitcnt vmcnt(" #n ")" ::: "memory")
#define PG8_WAIT_L(n) asm volatile("s_waitcnt lgkmcnt(" #n ")" ::: "memory")
#define PG8_BAR __builtin_amdgcn_s_barrier()
#define PG8_SCHED __builtin_amdgcn_sched_barrier(0)
    Unit cur, nxt; int ui = 0;
    if (!S.next(0, cur)) return;
    f32x4 acc[2][2][4][2];
#pragma unroll
    for (int a = 0; a < 2; ++a)
#pragma unroll
        for (int b = 0; b < 2; ++b)
#pragma unroll
            for (int m = 0; m < 4; ++m)
#pragma unroll
                for (int n = 0; n < 2; ++n) acc[a][b][m][n] = (f32x4){0.f, 0.f, 0.f, 0.f};
    bf16x8 At[4][2], B0[2][2], B1[2][2];
    const char* cA = (const char*)g.A + (size_t)cur.pm * tstep; const char* cB = (const char*)g.Bt + (size_t)cur.pn * tstep;
    S.a_ready(cur);
    if constexpr (SP2) {
        PG8_STAGE(PG8_SB(0, 0), cB, voffB); PG8_STAGE(PG8_SB(0, 1), cB + hstep, voffB); PG8_STAGE(PG8_SA(0, 0), cA, voffA); PG8_STAGE(PG8_SA(0, 1), cA + hstep, voffA);
        if (wr == 1) PG8_BAR;
        PG8_WAIT_V(2); PG8_BAR;
        PG8_STAGE(PG8_SB(1, 0), cB + kstep, voffB); PG8_STAGE(PG8_SA(1, 0), cA + kstep, voffA); PG8_STAGE(PG8_SB(1, 1), cB + hstep + kstep, voffB);
        PG8_WAIT_V(6); PG8_BAR;
    } else {
        PG8_STAGE(PG8_SB(0, 0), cB, voffB); PG8_STAGE(PG8_SA(0, 0), cA, voffA); PG8_STAGE(PG8_SB(0, 1), cB + hstep, voffB); PG8_STAGE(PG8_SA(0, 1), cA + hstep, voffA);
        if (wr == 1) PG8_BAR;
        PG8_WAIT_V(4); PG8_BAR;
        PG8_STAGE(PG8_SB(1, 0), cB + kstep, voffB); PG8_STAGE(PG8_SA(1, 0), cA + kstep, voffA); PG8_STAGE(PG8_SB(1, 1), cB + hstep + kstep, voffB);
        PG8_WAIT_V(6); PG8_BAR;
    }
    for (;;) {
        const bool has_next = S.next(ui + 1, nxt);
        const char* nA = has_next ? (const char*)g.A + (size_t)nxt.pm * tstep : cA; const char* nB = has_next ? (const char*)g.Bt + (size_t)nxt.pn * tstep : cB;
        for (int t = 0; t < nt; t += 2) {
            const bool last = (t == nt - 2);
            const char* a1 = cA + (size_t)(t + 1) * kstep;
            const char* a2 = last ? nA : cA + (size_t)(t + 2) * kstep; const char* b2 = last ? nB : cB + (size_t)(t + 2) * kstep;
            const char* a3 = a2 + kstep; const char* b3 = b2 + kstep;
            if (last && has_next) S.a_ready(nxt);
            if constexpr (SP2) {
            PG8_LDB(B0, 0, 0); PG8_LDB(B1, 0, 1); PG8_SCHED; PG8_LDA(At, 0, 0); PG8_STAGE(PG8_SA(1, 1), a1 + hstep, voffA);
            PG8_WAIT_V(8); PG8_WAIT_L(0); PG8_BAR; PG8_MMA(0, 0, At, B0); PG8_MMA(0, 1, At, B1); PG8_BAR; PG8_SCHED;
            PG8_LDA(At, 0, 1); PG8_STAGE(PG8_SB(0, 0), b2, voffB); PG8_STAGE(PG8_SB(0, 1), b2 + hstep, voffB); PG8_STAGE(PG8_SA(0, 0), a2, voffA);
            PG8_WAIT_V(8); PG8_WAIT_L(0); PG8_BAR; PG8_MMA(1, 0, At, B0); PG8_MMA(1, 1, At, B1); PG8_BAR; PG8_SCHED;
            PG8_LDB(B0, 1, 0); PG8_LDB(B1, 1, 1); PG8_SCHED; PG8_LDA(At, 1, 0); PG8_STAGE(PG8_SA(0, 1), a2 + hstep, voffA);
            PG8_WAIT_V(8); PG8_WAIT_L(0); PG8_BAR; PG8_MMA(0, 0, At, B0); PG8_MMA(0, 1, At, B1); PG8_BAR; PG8_SCHED;
            PG8_LDA(At, 1, 1); PG8_STAGE(PG8_SB(1, 0), b3, voffB); PG8_STAGE(PG8_SB(1, 1), b3 + hstep, voffB); PG8_STAGE(PG8_SA(1, 0), a3, voffA);
            PG8_WAIT_V(8); PG8_WAIT_L(0); PG8_BAR; PG8_MMA(1, 0, At, B0); PG8_MMA(1, 1, At, B1); PG8_BAR; PG8_SCHED;
            } else {
            PG8_LDB(B0, 0, 0); PG8_SCHED; PG8_LDA(At, 0, 0); PG8_STAGE(PG8_SA(1, 1), a1 + hstep, voffA);
            PG8_WAIT_L(8); PG8_BAR; PG8_WAIT_L(0); PG8_MMA(0, 0, At, B0); PG8_BAR; PG8_SCHED;
            PG8_LDB(B1, 0, 1); PG8_STAGE(PG8_SB(0, 0), b2, voffB);
            PG8_BAR; PG8_WAIT_L(0); PG8_MMA(0, 1, At, B1); PG8_BAR;
            PG8_LDA(At, 0, 1); PG8_STAGE(PG8_SA(0, 0), a2, voffA);
            PG8_BAR; PG8_WAIT_L(0); PG8_MMA(1, 0, At, B0); PG8_BAR; PG8_SCHED;
            PG8_STAGE(PG8_SB(0, 1), b2 + hstep, voffB);
            PG8_WAIT_V(6); PG8_BAR; PG8_MMA(1, 1, At, B1); PG8_BAR;
            PG8_LDB(B0, 1, 0); PG8_SCHED; PG8_LDA(At, 1, 0); PG8_STAGE(PG8_SA(0, 1), a2 + hstep, voffA);
            PG8_WAIT_L(8); PG8_BAR; PG8_WAIT_L(0); PG8_MMA(0, 0, At, B0); PG8_BAR; PG8_SCHED;
            PG8_LDB(B1, 1, 1); PG8_STAGE(PG8_SB(1, 0), b3, voffB);
            PG8_BAR; PG8_WAIT_L(0); PG8_MMA(0, 1, At, B1); PG8_BAR;
            PG8_LDA(At, 1, 1); PG8_STAGE(PG8_SA(1, 0), a3, voffA);
            PG8_BAR; PG8_WAIT_L(0); PG8_MMA(1, 0, At, B0); PG8_BAR; PG8_SCHED;
            PG8_STAGE(PG8_SB(1, 1), b3 + hstep, voffB);
            PG8_WAIT_V(6); PG8_BAR; PG8_MMA(1, 1, At, B1); PG8_BAR;
            }
        }
        if constexpr (ALIGN_EPI) { if (wr == 0) PG8_BAR; }
        if constexpr (!Epi::AFTER_DRAIN) { E(acc, cur, wr, wc, fr, fq); S.done(cur); }
        if (!has_next) break;
#pragma unroll
        for (int a = 0; a < 2; ++a)
#pragma unroll
            for (int b = 0; b < 2; ++b)
#pragma unroll
                for (int m = 0; m < 4; ++m)
#pragma unroll
                    for (int n = 0; n < 2; ++n) acc[a][b][m][n] = (f32x4){0.f, 0.f, 0.f, 0.f};
        cur = nxt; cA = nA; cB = nB; ++ui;
        if constexpr (ALIGN_EPI) { if (wr == 1) PG8_BAR; }
    }
    PG8_WAIT_V(0);
    if constexpr (!ALIGN_EPI) { if (wr == 0) PG8_BAR; }
    PG8_BAR;
    if constexpr (Epi::AFTER_DRAIN) { E.fused(acc, cur, wr, wc, fr, fq, lds, wid, lane); S.done(cur); }
#undef PG8_SA
#undef PG8_SB
#undef PG8_STAGE
#undef PG8_LDA
#undef PG8_LDB
#undef PG8_MMA
#undef PG8_WAIT_V
#undef PG8_WAIT_L
#undef PG8_BAR
#undef PG8_SCHED
}
}
#define GAS __attribute__((address_space(1)))
#define LAS __attribute__((address_space(3)))
typedef unsigned short bf16;
typedef unsigned v4u __attribute__((ext_vector_type(4)));
typedef float f32x4 __attribute__((ext_vector_type(4)));
typedef short bf16x8 __attribute__((ext_vector_type(8)));
typedef GAS unsigned gu32;
typedef GAS unsigned long long gu64;
#define RLX_AGENT __ATOMIC_RELAXED, __HIP_MEMORY_SCOPE_AGENT
#define LDS_WAIT() asm volatile("s_waitcnt lgkmcnt(0)" ::: "memory")
#define VM_WAIT() asm volatile("s_waitcnt vmcnt(0)" ::: "memory")
__device__ __forceinline__ unsigned long long rt() { return __builtin_amdgcn_s_memrealtime(); }
__device__ __forceinline__ unsigned f2bf(float f) { unsigned u = __builtin_bit_cast(unsigned, f); return (u + 0x7fffu + ((u >> 16) & 1u)) >> 16; }
__device__ __forceinline__ unsigned pk2(float lo, float hi) { return f2bf(lo) | (f2bf(hi) << 16); }

#define XB_TMO      128
#define XB_XCNT(j)  (256  + 64 * (j))
#define XB_XSUB(j)  (1280 + 64 * (j))
#define XB_XGEN(j)  (2304 + 64 * (j))
#define XB_TOP      3328
#define XB_TOPGEN   3392
#define XCD_BAR_WORDS 3456
#define XB_SPIN_CAP (1u << 18)

__device__ __forceinline__ unsigned xb_ld(unsigned* p)              { return __hip_atomic_load(p, __ATOMIC_RELAXED, __HIP_MEMORY_SCOPE_AGENT); }
__device__ __forceinline__ unsigned xb_add(unsigned* p, unsigned v) { return __hip_atomic_fetch_add(p, v, __ATOMIC_RELAXED, __HIP_MEMORY_SCOPE_AGENT); }
__device__ __forceinline__ unsigned xb_xcc_id() { return (unsigned)__builtin_amdgcn_s_getreg((3 << 11) | 20) & 0xFu; }
#define XB_SPIN(cond, bar) do { unsigned _sp = 0; while (cond) { __builtin_amdgcn_s_sleep(1); \
    if ((++_sp & 255u) == 0u) { if (xb_ld(&(bar)[XB_TMO])) break; if (_sp > XB_SPIN_CAP) { atomicAdd(&(bar)[XB_TMO], 1u); break; } } } } while (0)

struct XcdBarrier {
    unsigned* bar; unsigned x;
    volatile LAS unsigned* st;
};

__device__ __forceinline__ XcdBarrier xcd_barrier_post(unsigned* bar, volatile LAS unsigned* st) {
    XcdBarrier b; b.bar = bar; b.x = xb_xcc_id(); b.st = st;
    if (threadIdx.x == 0) (void)xb_add(&bar[XB_XCNT(b.x)], 1u);
    return b;
}
__device__ __forceinline__ void xcd_barrier_complete(unsigned* bar, unsigned x, unsigned& nloc, unsigned& nx) {
    const unsigned G = gridDim.x * gridDim.y * gridDim.z;
    unsigned sum, cnt, mine, sp = 0u;
    for (;;) {
        sum = 0u; cnt = 0u; mine = 0u;
#pragma unroll
        for (unsigned j = 0; j < 16; ++j) { const unsigned c = xb_ld(&bar[XB_XCNT(j)]); sum += c; cnt += (c > 0u) ? 1u : 0u; mine = (j == x) ? c : mine; }
        if (sum == G) break;
        __builtin_amdgcn_s_sleep(1);
        if ((++sp & 255u) == 0u) { if (xb_ld(&bar[XB_TMO])) break; if (sp > XB_SPIN_CAP) { atomicAdd(&bar[XB_TMO], 1u); break; } }
    }
    nloc = mine > 0u ? mine : 1u; nx = cnt > 0u ? cnt : 1u;
}

__device__ __forceinline__ void xcd_barrier(const XcdBarrier& b) {
    asm volatile("s_waitcnt vmcnt(0)" ::: "memory");
    __syncthreads();
    if (threadIdx.x == 0) {
        unsigned* bar = b.bar;
        __builtin_amdgcn_s_waitcnt(0);
        unsigned nloc = b.st[0], nx = b.st[1];
        if (nloc == 0u) { xcd_barrier_complete(bar, b.x, nloc, nx); b.st[0] = nloc; b.st[1] = nx; }
        const unsigned old = xb_add(&bar[XB_XSUB(b.x)], 1u);
        const unsigned gen = old / nloc;
        if (old + 1u == (gen + 1u) * nloc) {
            __builtin_amdgcn_fence(__ATOMIC_RELEASE, "agent");
            asm volatile("s_waitcnt vmcnt(0)" ::: "memory");
            const unsigned og = xb_add(&bar[XB_TOP], 1u);
            const unsigned tg = og / nx;
            if (og + 1u == (tg + 1u) * nx) xb_add(&bar[XB_TOPGEN], 1u);
            else XB_SPIN(xb_ld(&bar[XB_TOPGEN]) == tg, bar);
            __builtin_amdgcn_fence(__ATOMIC_ACQUIRE, "agent");
            xb_add(&bar[XB_XGEN(b.x)], 1u);
            asm volatile("s_waitcnt vmcnt(0)" ::: "memory");
        } else {
            XB_SPIN(xb_ld(&bar[XB_XGEN(b.x)]) == gen, bar);
            __builtin_amdgcn_fence(__ATOMIC_ACQUIRE, "agent");
            asm volatile("s_waitcnt vmcnt(0)" ::: "memory");
        }
    }
    __syncthreads();
}

constexpr int NWAVES = 8;
constexpr int DM = 1024, BATCH = 16, SEQ = 2048, DEPTH = 2, HD = 64, NH = 8, NGRP = 8, AW = 512, GWD = 512, INW = 2560, MOBA = 256, NBLK = SEQ / MOBA, GCH = 128, DFF = 2816, PLE = 256;
constexpr int M = BATCH * SEQ;
constexpr float RMS_EPS = 1e-6f, LN_EPS = 1e-5f;
constexpr float LOG2E = 1.4426950408889634f;
constexpr float QSCALE = 0.125f * LOG2E;

constexpr size_t MiB = 1u << 20;
constexpr size_t WS_CTL = 0, CTL_ZERO_BYTES = 1 * MiB;
constexpr size_t WL_GU1 = 0, WL_D1 = WL_GU1 + (size_t)2 * DFF * DM * 2, WL_GU2 = WL_D1 + (size_t)DM * DFF * 2, WL_D2 = WL_GU2 + (size_t)2 * DFF * DM * 2,
                 WL_IN = WL_D2 + (size_t)DM * DFF * 2, WL_OUT = WL_IN + (size_t)INW * DM * 2, WL_PG = WL_OUT + (size_t)DM * DM * 2, WL_PP = WL_PG + (size_t)DM * DM * 2, WL_STRIDE = WL_PP + (size_t)DM * PLE * 2;
constexpr size_t WS_W = 2 * MiB;
static_assert(WS_W + 2 * WL_STRIDE <= 88 * MiB, "weights");
constexpr size_t WS_PBF = 88 * MiB;
constexpr size_t WS_XN = 120 * MiB;
constexpr size_t WS_HB = 184 * MiB;
constexpr size_t WS_MRG = 360 * MiB;
constexpr size_t WS_FB = 424 * MiB;
constexpr size_t WS_KM = 488 * MiB;
constexpr size_t WS_SSQ = 489 * MiB;
constexpr size_t WS_END = 490 * MiB;
constexpr size_t ZSTRIDE = (size_t)M * 512;
static_assert(WS_HB + (size_t)M * DFF * 2 <= WS_MRG && 5 * ZSTRIDE * 2 <= (size_t)M * DFF * 2, "overlay");
constexpr int CW_TMO = 0, CW_CODE = 1, CW_BAR = 4096;

constexpr int RING_OFF = 0, RING_BYTES = 131072;
constexpr int LDSCTL_OFF = RING_BYTES, MISC_OFF = LDSCTL_OFF + 320, EXTRA_OFF = RING_BYTES + 1024;
constexpr int LDS_BYTES = 147456;

struct Frame {
    LAS unsigned char* lds;
    volatile LAS unsigned* MISC;
    gu32* ctl;
    int tid, lane, wave, G;
    float* out; unsigned char* ws;
};
enum { I_X = 0, I_P, I_F1PRE, I_F1G, I_F1U, I_F1D, I_F1POST, I_MIXPRE, I_WIN, I_LNG, I_LNB, I_WS, I_BS, I_AON, I_GON, I_WOUT, I_MIXPOST, I_F2PRE, I_F2G, I_F2U, I_F2D, I_F2POST, I_PLEPRE, I_PLEG, I_PLEP, I_PLEPOST };

__device__ __forceinline__ float wave_sum(float v) {
#pragma unroll
    for (int o = 1; o < 64; o <<= 1) v += __shfl_xor(v, o);
    return v;
}
__device__ __forceinline__ float wave_max(float v) {
#pragma unroll
    for (int o = 1; o < 64; o <<= 1) v = fmaxf(v, __shfl_xor(v, o));
    return v;
}
__device__ __forceinline__ float bf2f(bf16 b) { return __uint_as_float((unsigned)b << 16); }
__device__ __forceinline__ int fresh_lane() { int l = (int)(threadIdx.x & 63u); asm volatile("" : "+v"(l)); return l; }

__device__ __forceinline__ void p0_transpose_item(const float* W, int K, int N, bf16* WT, LAS float* scr, int k0, int n0, int drow0, const float* gk, int lane) {
#pragma unroll 8
    for (int i = 0; i < 32; ++i) { const int kk = 2 * i + (lane >> 5); const float g = gk ? gk[kk] : 1.0f; scr[kk * 33 + (lane & 31)] = W[(size_t)(k0 + kk) * N + n0 + (lane & 31)] * g; }
    LDS_WAIT(); asm volatile("" ::: "memory");
    const int c = lane & 7;
#pragma unroll
    for (int j = 0; j < 4; ++j) { const int n = (lane >> 3) + 8 * j; const LAS float* s = scr + (8 * c) * 33 + n;
        v4u o; o.x = pk2(s[0 * 33], s[1 * 33]); o.y = pk2(s[2 * 33], s[3 * 33]); o.z = pk2(s[4 * 33], s[5 * 33]); o.w = pk2(s[6 * 33], s[7 * 33]);
        *(GAS v4u*)(WT + (size_t)(drow0 + n) * K + k0 + 8 * c) = o; }
    LDS_WAIT(); asm volatile("" ::: "memory");
}
__device__ __forceinline__ bool p0_matrix(int& r, const float* W, int K, int N, bf16* WT, int mode, const float* gain, const float* gain2, LAS float* scr, int lane) {
    const int nblk = N / 32, items = (K / 64) * nblk;
    if (r >= items) { r -= items; return false; }
    const int kb = r / nblk, nb = r % nblk, k0 = 64 * kb, n0 = 32 * nb;
    const int drow0 = (mode == 0) ? n0 : ((n0 >> 7) * 256 + (n0 & 127) + (mode == 2 ? 128 : 0));
    const float* gk = gain ? ((gain2 && k0 >= 512) ? gain2 + (k0 - 512) : gain + k0) : nullptr;
    p0_transpose_item(W, K, N, WT, scr, k0, n0, drow0, gk, lane);
    return true;
}
__device__ __forceinline__ void rms_row_to_bf16(const float* xrow, bf16* orow, int lane) {
    const GAS f32x4* xr = (const GAS f32x4*)xrow + lane;
    f32x4 v[4]; float s = 0.f;
#pragma unroll
    for (int j = 0; j < 4; ++j) { v[j] = xr[64 * j]; s += (v[j].x * v[j].x + v[j].y * v[j].y) + (v[j].z * v[j].z + v[j].w * v[j].w); }
    const float r = 1.0f / sqrtf(wave_sum(s) * (1.f / DM) + RMS_EPS);
    GAS unsigned long long* o8 = (GAS unsigned long long*)orow + lane;
#pragma unroll
    for (int j = 0; j < 4; ++j) o8[64 * j] = (unsigned long long)pk2(v[j].x * r, v[j].y * r) | ((unsigned long long)pk2(v[j].z * r, v[j].w * r) << 32);
}
struct Args { const float* in[26]; float* out; unsigned char* ws; };
__device__ __forceinline__ void p0_prologue(Frame& F, const Args& A) {
    LAS float* scr = (LAS float*)(F.lds + RING_OFF + F.wave * 16384);
    const int gw = blockIdx.x * NWAVES + F.wave, NGW = F.G * NWAVES;
    constexpr int ITEMS_L = 4 * (DM / 64) * (DFF / 32) + 2 * (DFF / 64) * (DM / 32) + (DM / 64) * (INW / 32) + 2 * (DM / 64) * (DM / 32) + (PLE / 64) * (DM / 32);
    for (int it = gw; it < DEPTH * ITEMS_L; it += NGW) {
        const int l = it / ITEMS_L; int r = it % ITEMS_L;
        bf16* wl = (bf16*)(F.ws + WS_W + (size_t)l * WL_STRIDE);
        if (p0_matrix(r, A.in[I_F1G] + (size_t)l * DM * DFF, DM, DFF, wl + WL_GU1 / 2, 1, A.in[I_F1PRE] + l * DM, nullptr, scr, F.lane)) continue;
        if (p0_matrix(r, A.in[I_F1U] + (size_t)l * DM * DFF, DM, DFF, wl + WL_GU1 / 2, 2, A.in[I_F1PRE] + l * DM, nullptr, scr, F.lane)) continue;
        if (p0_matrix(r, A.in[I_F1D] + (size_t)l * DFF * DM, DFF, DM, wl + WL_D1 / 2, 0, nullptr, nullptr, scr, F.lane)) continue;
        if (p0_matrix(r, A.in[I_F2G] + (size_t)l * DM * DFF, DM, DFF, wl + WL_GU2 / 2, 1, A.in[I_F2PRE] + l * DM, nullptr, scr, F.lane)) continue;
        if (p0_matrix(r, A.in[I_F2U] + (size_t)l * DM * DFF, DM, DFF, wl + WL_GU2 / 2, 2, A.in[I_F2PRE] + l * DM, nullptr, scr, F.lane)) continue;
        if (p0_matrix(r, A.in[I_F2D] + (size_t)l * DFF * DM, DFF, DM, wl + WL_D2 / 2, 0, nullptr, nullptr, scr, F.lane)) continue;
        if (p0_matrix(r, A.in[I_WIN] + (size_t)l * DM * INW, DM, INW, wl + WL_IN / 2, 0, A.in[I_MIXPRE] + l * DM, nullptr, scr, F.lane)) continue;
        if (p0_matrix(r, A.in[I_WOUT] + (size_t)l * DM * DM, DM, DM, wl + WL_OUT / 2, 0, A.in[I_AON] + l * AW, A.in[I_GON] + l * GWD, scr, F.lane)) continue;
        if (p0_matrix(r, A.in[I_PLEG] + (size_t)l * DM * DM, DM, DM, wl + WL_PG / 2, 0, A.in[I_PLEPRE] + l * DM, nullptr, scr, F.lane)) continue;
        p0_matrix(r, A.in[I_PLEP] + (size_t)l * PLE * DM, PLE, DM, wl + WL_PP / 2, 0, nullptr, nullptr, scr, F.lane);
    }
    { const GAS f32x4* p4 = (const GAS f32x4*)A.in[I_P]; GAS v4u* o = (GAS v4u*)(F.ws + WS_PBF); const int n8 = DEPTH * M * PLE / 8;
      for (int i = blockIdx.x * (NWAVES * 64) + F.tid; i < n8; i += F.G * NWAVES * 64) { const f32x4 a = p4[2 * i], b = p4[2 * i + 1]; v4u w; w.x = pk2(a.x, a.y); w.y = pk2(a.z, a.w); w.z = pk2(b.x, b.y); w.w = pk2(b.z, b.w); o[i] = w; } }
    for (int m = gw; m < M; m += NGW) rms_row_to_bf16(A.in[I_X] + (size_t)m * DM, (bf16*)(F.ws + WS_XN) + (size_t)m * DM, F.lane);
}

__device__ __forceinline__ void thin_phase(Frame& F, const bf16* Fb, const float* hin, float* hout, const float* gpost, float coef, bf16* xn) {
    const int gw = blockIdx.x * NWAVES + F.wave, NGW = F.G * NWAVES, lane = fresh_lane();
    f32x4 gp[4];
#pragma unroll
    for (int j = 0; j < 4; ++j) gp[j] = *((const GAS f32x4*)gpost + lane + 64 * j);
    for (int m = gw; m < M; m += NGW) {
        const GAS unsigned long long* fr = (const GAS unsigned long long*)(Fb + (size_t)m * DM) + lane;
        const GAS f32x4* hr = (const GAS f32x4*)(hin + (size_t)m * DM) + lane;
        f32x4 f[4], h[4]; float s = 0.f;
#pragma unroll
        for (int j = 0; j < 4; ++j) { const unsigned long long w = fr[64 * j]; h[j] = hr[64 * j];
            f[j].x = __uint_as_float((unsigned)w << 16); f[j].y = __uint_as_float((unsigned)w & 0xffff0000u); f[j].z = __uint_as_float((unsigned)(w >> 32) << 16); f[j].w = __uint_as_float((unsigned)(w >> 32) & 0xffff0000u);
            s += (f[j].x * f[j].x + f[j].y * f[j].y) + (f[j].z * f[j].z + f[j].w * f[j].w); }
        const float r = coef / sqrtf(wave_sum(s) * (1.f / DM) + RMS_EPS); float s2 = 0.f;
#pragma unroll
        for (int j = 0; j < 4; ++j) { h[j] = h[j] + f[j] * gp[j] * r; s2 += (h[j].x * h[j].x + h[j].y * h[j].y) + (h[j].z * h[j].z + h[j].w * h[j].w); }
        GAS f32x4* ho = (GAS f32x4*)(hout + (size_t)m * DM) + lane;
#pragma unroll
        for (int j = 0; j < 4; ++j) ho[64 * j] = h[j];
        if (xn) { const float r2 = 1.0f / sqrtf(wave_sum(s2) * (1.f / DM) + RMS_EPS);
            GAS unsigned long long* o8 = (GAS unsigned long long*)(xn + (size_t)m * DM) + lane;
#pragma unroll
            for (int j = 0; j < 4; ++j) o8[64 * j] = (unsigned long long)pk2(h[j].x * r2, h[j].y * r2) | ((unsigned long long)pk2(h[j].z * r2, h[j].w * r2) << 32); }
    }
}

__device__ __forceinline__ void gmlp_naive_phase(Frame& F, const float* ln_g, const float* ln_b, const float* w_s, const float* b_s) {
    const bf16* GU = (const bf16*)(F.ws + WS_HB) + 3 * ZSTRIDE; const bf16* GV = GU + ZSTRIDE; const bf16* KB = (const bf16*)(F.ws + WS_HB) + ZSTRIDE;
    bf16* MRG = (bf16*)(F.ws + WS_MRG);
    const int g = F.wave, lane = fresh_lane();
    LAS bf16* vn = (LAS bf16*)(F.lds + RING_OFF + g * 16384);
    LAS float* ssqt = (LAS float*)(F.lds + EXTRA_OFF);
    const float lg = ln_g[g * 64 + lane], lb = ln_b[g * 64 + lane];
    const float* w = w_s + (size_t)g * GCH * GCH; const float* bs = b_s + (size_t)g * GCH;
    for (int unit = blockIdx.x; unit < M / GCH; unit += F.G) {
        const size_t R0 = (size_t)unit * GCH;
        for (int s = 0; s < GCH; ++s) { const float v = bf2f(GV[(R0 + s) * 512 + g * 64 + lane]); const float mean = wave_sum(v) * (1.f / 64.f); const float d = v - mean;
            const float var = wave_sum(d * d) * (1.f / 64.f); const float y = d * (1.0f / sqrtf(var + LN_EPS)) * lg + lb; vn[s * 64 + lane] = (bf16)f2bf(y); }
        LDS_WAIT(); asm volatile("" ::: "memory");
        for (int t = 0; t < GCH; ++t) { float a = 0.f;
            for (int s = 0; s <= t; ++s) a += w[t * GCH + s] * bf2f(vn[s * 64 + lane]);
            a += bs[t];
            const float o = bf2f(GU[(R0 + t) * 512 + g * 64 + lane]) * a; const float ss = wave_sum(o * o);
            MRG[(R0 + t) * DM + AW + g * 64 + lane] = (bf16)f2bf(o); if (lane == 0) ssqt[t * 8 + g] = ss; }
        VM_WAIT(); LDS_WAIT(); __syncthreads();
        for (int t = 0; t < GCH; ++t) { float q = 0.f;
#pragma unroll
            for (int k = 0; k < 8; ++k) q += ssqt[t * 8 + k];
            const float r = 1.0f / sqrtf(q * (1.f / GWD) + RMS_EPS); bf16* p = MRG + (R0 + t) * DM + AW + g * 64 + lane; *p = (bf16)f2bf(bf2f(*p) * r); }
        LDS_WAIT(); __syncthreads();
    }
    float* KM = (float*)(F.ws + WS_KM);
    for (int item = blockIdx.x * NWAVES + F.wave; item < BATCH * NH * NBLK; item += F.G * NWAVES) {
        const int b = item >> 6, h = (item >> 3) & 7, n = item & 7; const bf16* kp = KB + ((size_t)b * SEQ + n * MOBA) * 512 + h * 64 + lane; float s = 0.f;
        for (int j = 0; j < MOBA; ++j) s += bf2f(kp[(size_t)j * 512]);
        KM[item * 64 + lane] = s * (1.f / MOBA);
    }
}

__device__ __forceinline__ void attn_naive_phase(Frame& F) {
    const bf16* Q = (const bf16*)(F.ws + WS_HB); const bf16* KB = Q + ZSTRIDE; const bf16* VB = KB + ZSTRIDE;
    bf16* MRG = (bf16*)(F.ws + WS_MRG); const float* KM = (const float*)(F.ws + WS_KM); float* SSQ = (float*)(F.ws + WS_SSQ);
    const int lane = fresh_lane(); LAS float* qsh = (LAS float*)(F.lds + RING_OFF + F.wave * 256);
    for (int idx = blockIdx.x * NWAVES + F.wave; idx < BATCH * NH * SEQ; idx += F.G * NWAVES) {
        const int bh = idx & 127, t = idx >> 7, b = bh >> 3, h = bh & 7, own = t >> 8; const size_t row = (size_t)b * SEQ + t;
        const float qd = bf2f(Q[row * 512 + h * 64 + lane]);
        const float sl2 = exp2f(-(float)(h + 1)) * LOG2E;
        float gv[NBLK - 1];
#pragma unroll
        for (int n = 0; n < NBLK - 1; ++n) { const float pr = (n < own) ? qd * KM[((size_t)bh * NBLK + n) * 64 + lane] : 0.f; const float sgate = wave_sum(pr); gv[n] = (n < own) ? sgate : -INFINITY; }
        unsigned mask = 0u;
#pragma unroll
        for (int k = 0; k < 3; ++k) { int best = -1; float bv = -INFINITY;
#pragma unroll
            for (int n = 0; n < NBLK - 1; ++n) if (!((mask >> n) & 1u) && gv[n] > bv) { bv = gv[n]; best = n; }
            if (best >= 0) mask |= 1u << best; }
        mask = (unsigned)__builtin_amdgcn_readfirstlane((int)mask);
        qsh[lane] = qd; LDS_WAIT(); asm volatile("" ::: "memory");
        float mrun = -INFINITY, lrun = 0.f, o = 0.f;
        for (int bi = 0; bi <= NBLK - 1; ++bi) {
            int nb; if (bi == 0) nb = own; else { nb = bi - 1; if (!((mask >> nb) & 1u)) continue; }
            for (int tile = 0; tile < 4; ++tile) {
                const int s0 = nb * MOBA + tile * 64; if (s0 > t) break;
                const int s = s0 + lane; const GAS v4u* kr = (const GAS v4u*)(KB + ((size_t)b * SEQ + s) * 512 + h * 64);
                float dot = 0.f;
#pragma unroll
                for (int c = 0; c < 8; ++c) { const v4u kk = kr[c]; float qs[64]; { const f32x4 qa = *(const LAS f32x4*)(qsh + 8 * c), qb = *(const LAS f32x4*)(qsh + 8 * c + 4); qs[8*c]=qa.x; qs[8*c+1]=qa.y; qs[8*c+2]=qa.z; qs[8*c+3]=qa.w; qs[8*c+4]=qb.x; qs[8*c+5]=qb.y; qs[8*c+6]=qb.z; qs[8*c+7]=qb.w; }
                    dot += qs[8 * c + 0] * __uint_as_float(kk.x << 16) + qs[8 * c + 1] * __uint_as_float(kk.x & 0xffff0000u) + qs[8 * c + 2] * __uint_as_float(kk.y << 16) + qs[8 * c + 3] * __uint_as_float(kk.y & 0xffff0000u)
                         + qs[8 * c + 4] * __uint_as_float(kk.z << 16) + qs[8 * c + 5] * __uint_as_float(kk.z & 0xffff0000u) + qs[8 * c + 6] * __uint_as_float(kk.w << 16) + qs[8 * c + 7] * __uint_as_float(kk.w & 0xffff0000u); }
                float x = dot - sl2 * (float)(t - s); if (s > t) x = -INFINITY;
                const float mnew = fmaxf(mrun, wave_max(x)); const float p = exp2f(x - mnew), f = exp2f(mrun - mnew);
                lrun = lrun * f + wave_sum(p); o *= f; mrun = mnew;
                const bf16* vp = VB + ((size_t)b * SEQ + s0) * 512 + h * 64 + lane;
#pragma unroll 8
                for (int j = 0; j < 64; ++j) { const float pj = __uint_as_float((unsigned)__builtin_amdgcn_readlane((int)__float_as_uint(p), j)); o += pj * bf2f(vp[(size_t)j * 512]); }
            }
        }
        const float res = o / lrun; const float ss = wave_sum(res * res);
        MRG[row * DM + h * 64 + lane] = (bf16)f2bf(res); if (lane == 0) SSQ[row * NH + h] = ss;
    }
}
__device__ __forceinline__ void attn_norm_phase(Frame& F) {
    bf16* MRG = (bf16*)(F.ws + WS_MRG); const float* SSQ = (const float*)(F.ws + WS_SSQ); const int lane = fresh_lane();
    for (int m = blockIdx.x * NWAVES + F.wave; m < M; m += F.G * NWAVES) {
        float q = 0.f;
#pragma unroll
        for (int k = 0; k < NH; ++k) q += SSQ[(size_t)m * NH + k];
        const float r = 1.0f / sqrtf(q * (1.f / AW) + RMS_EPS);
        GAS v4u* p = (GAS v4u*)(MRG + (size_t)m * DM) + lane; v4u w = *p;
        w.x = pk2(__uint_as_float(w.x << 16) * r, __uint_as_float(w.x & 0xffff0000u) * r); w.y = pk2(__uint_as_float(w.y << 16) * r, __uint_as_float(w.y & 0xffff0000u) * r);
        w.z = pk2(__uint_as_float(w.z << 16) * r, __uint_as_float(w.z & 0xffff0000u) * r); w.w = pk2(__uint_as_float(w.w << 16) * r, __uint_as_float(w.w & 0xffff0000u) * r);
        *p = w;
    }
}

#ifndef PG8_SP2
#define PG8_SP2 true
#endif
#ifndef PG8_ALIGN
#define PG8_ALIGN true
#endif
__global__ void __launch_bounds__(NWAVES * 64, 2) mk_fwd(Args args) {
    extern __shared__ __attribute__((aligned(16))) unsigned char lds[];
    Frame F;
    F.lds = (LAS unsigned char*)lds; F.MISC = (volatile LAS unsigned*)(F.lds + MISC_OFF);
    F.tid = threadIdx.x; F.lane = F.tid & 63; F.wave = __builtin_amdgcn_readfirstlane(F.tid >> 6); F.G = gridDim.x;
    F.ws = args.ws; F.out = args.out; F.ctl = (gu32*)(args.ws + WS_CTL);
    for (int u = F.tid; u < (LDS_BYTES - LDSCTL_OFF) / 4; u += NWAVES * 64) ((LAS unsigned*)(F.lds + LDSCTL_OFF))[u] = 0u;
    __syncthreads();
    XcdBarrier bar = xcd_barrier_post((unsigned*)(F.ctl + CW_BAR), F.MISC + 8);
#define GRID_BAR() xcd_barrier(bar)
    using pg8::bf16_t;
    bf16_t* XN = (bf16_t*)(F.ws + WS_XN); bf16_t* HB = (bf16_t*)(F.ws + WS_HB); bf16_t* MRG = (bf16_t*)(F.ws + WS_MRG); bf16_t* FB = (bf16_t*)(F.ws + WS_FB);

    p0_prologue(F, args); GRID_BAR();

        { constexpr int l = 0;

    {
        const bf16_t* wl = (const bf16_t*)(F.ws + WS_W + (size_t)l * WL_STRIDE);
        { pg8::Gemm g{XN, wl + WL_GU1 / 2, M, 2 * DFF, DM}; pg8::StaticOrder S; S.init(M, 2 * DFF, F.G, (int)blockIdx.x); pg8::EpiSwiGLU E{HB, DFF};
          pg8::gemm_phase<pg8::EpiSwiGLU, pg8::StaticOrder, PG8_ALIGN, PG8_SP2>(F.lds + RING_OFF, g, S, E); }
        GRID_BAR();
        { pg8::Gemm g{HB, wl + WL_D1 / 2, M, DM, DFF}; pg8::StaticOrder S; S.init(M, DM, F.G, (int)blockIdx.x); pg8::EpiBf16<0> E{FB, DM, nullptr, 0, 0, 1.f};
          pg8::gemm_phase<pg8::EpiBf16<0>, pg8::StaticOrder, PG8_ALIGN, PG8_SP2>(F.lds + RING_OFF, g, S, E); }
        GRID_BAR();
        thin_phase(F, (const bf16*)FB, l == 0 ? args.in[I_X] : F.out, F.out, args.in[I_F1POST] + l * DM, 0.5f, (bf16*)XN);
        GRID_BAR();
        { pg8::Gemm g{XN, wl + WL_IN / 2, M, INW, DM}; pg8::StaticOrder S; S.init(M, INW, F.G, (int)blockIdx.x); pg8::EpiInProj E{HB, ZSTRIDE, QSCALE};
          pg8::gemm_phase<pg8::EpiInProj, pg8::StaticOrder, PG8_ALIGN, PG8_SP2>(F.lds + RING_OFF, g, S, E); }
        GRID_BAR();
        gmlp_naive_phase(F, args.in[I_LNG] + l * GWD, args.in[I_LNB] + l * GWD, args.in[I_WS] + (size_t)l * NGRP * GCH * GCH, args.in[I_BS] + (size_t)l * NGRP * GCH);
        GRID_BAR();
        attn_naive_phase(F);
        GRID_BAR();
        attn_norm_phase(F);
        GRID_BAR();
        { pg8::Gemm g{MRG, wl + WL_OUT / 2, M, DM, DM}; pg8::StaticOrder S; S.init(M, DM, F.G, (int)blockIdx.x); pg8::EpiBf16<0> E{FB, DM, nullptr, 0, 0, 1.f};
          pg8::gemm_phase<pg8::EpiBf16<0>, pg8::StaticOrder, PG8_ALIGN, PG8_SP2>(F.lds + RING_OFF, g, S, E); }
        GRID_BAR();
        thin_phase(F, (const bf16*)FB, F.out, F.out, args.in[I_MIXPOST] + l * DM, 1.0f, (bf16*)XN);
        GRID_BAR();
        { pg8::Gemm g{XN, wl + WL_GU2 / 2, M, 2 * DFF, DM}; pg8::StaticOrder S; S.init(M, 2 * DFF, F.G, (int)blockIdx.x); pg8::EpiSwiGLU E{HB, DFF};
          pg8::gemm_phase<pg8::EpiSwiGLU, pg8::StaticOrder, PG8_ALIGN, PG8_SP2>(F.lds + RING_OFF, g, S, E); }
        GRID_BAR();
        { pg8::Gemm g{HB, wl + WL_D2 / 2, M, DM, DFF}; pg8::StaticOrder S; S.init(M, DM, F.G, (int)blockIdx.x); pg8::EpiBf16<0> E{FB, DM, nullptr, 0, 0, 1.f};
          pg8::gemm_phase<pg8::EpiBf16<0>, pg8::StaticOrder, PG8_ALIGN, PG8_SP2>(F.lds + RING_OFF, g, S, E); }
        GRID_BAR();
        { pg8::Gemm g{(const bf16_t*)(F.ws + WS_PBF) + (size_t)l * M * PLE, wl + WL_PP / 2, M, DM, PLE}; pg8::StaticOrder S; S.init(M, DM, F.G, (int)blockIdx.x); pg8::EpiBf16<0> E{HB, DM, nullptr, 0, 0, 1.f};
          pg8::gemm_phase<pg8::EpiBf16<0>, pg8::StaticOrder, PG8_ALIGN, PG8_SP2>(F.lds + RING_OFF, g, S, E); }
        thin_phase(F, (const bf16*)FB, F.out, F.out, args.in[I_F2POST] + l * DM, 0.5f, (bf16*)XN);
        GRID_BAR();
        { pg8::Gemm g{XN, wl + WL_PG / 2, M, DM, DM}; pg8::StaticOrder S; S.init(M, DM, F.G, (int)blockIdx.x); pg8::EpiPleGate E{FB, HB, DM};
          pg8::gemm_phase<pg8::EpiPleGate, pg8::StaticOrder, PG8_ALIGN, PG8_SP2>(F.lds + RING_OFF, g, S, E); }
        GRID_BAR();
        thin_phase(F, (const bf16*)FB, F.out, F.out, args.in[I_PLEPOST] + l * DM, 1.0f, l + 1 < DEPTH ? (bf16*)XN : (bf16*)nullptr);
        if (l + 1 < DEPTH) GRID_BAR();
    }
        }
    { constexpr int l = 1;

    {
        const bf16_t* wl = (const bf16_t*)(F.ws + WS_W + (size_t)l * WL_STRIDE);
        { pg8::Gemm g{XN, wl + WL_GU1 / 2, M, 2 * DFF, DM}; pg8::StaticOrder S; S.init(M, 2 * DFF, F.G, (int)blockIdx.x); pg8::EpiSwiGLU E{HB, DFF};
          pg8::gemm_phase<pg8::EpiSwiGLU, pg8::StaticOrder, PG8_ALIGN, PG8_SP2>(F.lds + RING_OFF, g, S, E); }
        GRID_BAR();
        { pg8::Gemm g{HB, wl + WL_D1 / 2, M, DM, DFF}; pg8::StaticOrder S; S.init(M, DM, F.G, (int)blockIdx.x); pg8::EpiBf16<0> E{FB, DM, nullptr, 0, 0, 1.f};
          pg8::gemm_phase<pg8::EpiBf16<0>, pg8::StaticOrder, PG8_ALIGN, PG8_SP2>(F.lds + RING_OFF, g, S, E); }
        GRID_BAR();
        thin_phase(F, (const bf16*)FB, l == 0 ? args.in[I_X] : F.out, F.out, args.in[I_F1POST] + l * DM, 0.5f, (bf16*)XN);
        GRID_BAR();
        { pg8::Gemm g{XN, wl + WL_IN / 2, M, INW, DM}; pg8::StaticOrder S; S.init(M, INW, F.G, (int)blockIdx.x); pg8::EpiInProj E{HB, ZSTRIDE, QSCALE};
          pg8::gemm_phase<pg8::EpiInProj, pg8::StaticOrder, PG8_ALIGN, PG8_SP2>(F.lds + RING_OFF, g, S, E); }
        GRID_BAR();
        gmlp_naive_phase(F, args.in[I_LNG] + l * GWD, args.in[I_LNB] + l * GWD, args.in[I_WS] + (size_t)l * NGRP * GCH * GCH, args.in[I_BS] + (size_t)l * NGRP * GCH);
        GRID_BAR();
        attn_naive_phase(F);
        GRID_BAR();
        attn_norm_phase(F);
        GRID_BAR();
        { pg8::Gemm g{MRG, wl + WL_OUT / 2, M, DM, DM}; pg8::StaticOrder S; S.init(M, DM, F.G, (int)blockIdx.x); pg8::EpiBf16<0> E{FB, DM, nullptr, 0, 0, 1.f};
          pg8::gemm_phase<pg8::EpiBf16<0>, pg8::StaticOrder, PG8_ALIGN, PG8_SP2>(F.lds + RING_OFF, g, S, E); }
        GRID_BAR();
        thin_phase(F, (const bf16*)FB, F.out, F.out, args.in[I_MIXPOST] + l * DM, 1.0f, (bf16*)XN);
        GRID_BAR();
        { pg8::Gemm g{XN, wl + WL_GU2 / 2, M, 2 * DFF, DM}; pg8::StaticOrder S; S.init(M, 2 * DFF, F.G, (int)blockIdx.x); pg8::EpiSwiGLU E{HB, DFF};
          pg8::gemm_phase<pg8::EpiSwiGLU, pg8::StaticOrder, PG8_ALIGN, PG8_SP2>(F.lds + RING_OFF, g, S, E); }
        GRID_BAR();
        { pg8::Gemm g{HB, wl + WL_D2 / 2, M, DM, DFF}; pg8::StaticOrder S; S.init(M, DM, F.G, (int)blockIdx.x); pg8::EpiBf16<0> E{FB, DM, nullptr, 0, 0, 1.f};
          pg8::gemm_phase<pg8::EpiBf16<0>, pg8::StaticOrder, PG8_ALIGN, PG8_SP2>(F.lds + RING_OFF, g, S, E); }
        GRID_BAR();
        { pg8::Gemm g{(const bf16_t*)(F.ws + WS_PBF) + (size_t)l * M * PLE, wl + WL_PP / 2, M, DM, PLE}; pg8::StaticOrder S; S.init(M, DM, F.G, (int)blockIdx.x); pg8::EpiBf16<0> E{HB, DM, nullptr, 0, 0, 1.f};
          pg8::gemm_phase<pg8::EpiBf16<0>, pg8::StaticOrder, PG8_ALIGN, PG8_SP2>(F.lds + RING_OFF, g, S, E); }
        thin_phase(F, (const bf16*)FB, F.out, F.out, args.in[I_F2POST] + l * DM, 0.5f, (bf16*)XN);
        GRID_BAR();
        { pg8::Gemm g{XN, wl + WL_PG / 2, M, DM, DM}; pg8::StaticOrder S; S.init(M, DM, F.G, (int)blockIdx.x); pg8::EpiPleGate E{FB, HB, DM};
          pg8::gemm_phase<pg8::EpiPleGate, pg8::StaticOrder, PG8_ALIGN, PG8_SP2>(F.lds + RING_OFF, g, S, E); }
        GRID_BAR();
        thin_phase(F, (const bf16*)FB, F.out, F.out, args.in[I_PLEPOST] + l * DM, 1.0f, l + 1 < DEPTH ? (bf16*)XN : (bf16*)nullptr);
        if (l + 1 < DEPTH) GRID_BAR();
    }
        }

}

extern "C" void kernel_launch(void* const* d_in, const int* in_sizes, int n_in, void* d_out, int out_size, void* d_ws, size_t ws_size, hipStream_t stream) {
    static int grid = 0;
    if (grid == 0) {
        if (n_in != 26 || in_sizes[0] != M * DM || out_size != M * DM || ws_size < WS_END) { fprintf(stderr, "kernel_launch: unexpected shapes (n_in %d, in0 %d, out %d, ws %zu)\n", n_in, n_in > 0 ? in_sizes[0] : -1, out_size, ws_size); grid = -1; return; }
        int dev = 0, cus = 0, per_cu = 0;
        if (hipGetDevice(&dev) != hipSuccess || hipDeviceGetAttribute(&cus, hipDeviceAttributeMultiprocessorCount, dev) != hipSuccess) { grid = -1; return; }
        if (hipFuncSetAttribute((const void*)mk_fwd, hipFuncAttributeMaxDynamicSharedMemorySize, LDS_BYTES) != hipSuccess) { fprintf(stderr, "kernel_launch: hipFuncSetAttribute failed\n"); grid = -1; return; }
        if (hipOccupancyMaxActiveBlocksPerMultiprocessor(&per_cu, (const void*)mk_fwd, NWAVES * 64, LDS_BYTES) != hipSuccess || per_cu < 1) { fprintf(stderr, "kernel_launch: occupancy query reports %d\n", per_cu); }
        (void)hipGetLastError();
        grid = cus;
    }
    if (grid < 0) return;
    if (hipMemsetAsync((char*)d_ws + WS_CTL, 0, CTL_ZERO_BYTES, stream) != hipSuccess) return;
    Args a{};
    for (int i = 0; i < 26; ++i) a.in[i] = (const float*)d_in[i];
    a.out = (float*)d_out; a.ws = (unsigned char*)d_ws;
    hipLaunchKernelGGL(mk_fwd, dim3(grid), dim3(NWAVES * 64), LDS_BYTES, stream, a);
}
```

```cpp
#include <hip/hip_runtime.h>
#include <cstdio>
#include <cstdint>
#include <cmath>
namespace pg8 {
#define PG8_LAS __attribute__((address_space(3)))
typedef unsigned short bf16_t;
typedef short bf16x8 __attribute__((ext_vector_type(8)));
typedef float f32x4 __attribute__((ext_vector_type(4)));
typedef unsigned u32x4 __attribute__((ext_vector_type(4)));
constexpr int BM = 256, BK = 64, HALF = 128, HTB = HALF * BK * 2  , STAGE_BYTES = 8 * HTB, NXCD = 8, WGM = 8;

__host__ __device__ __forceinline__ int lds_byte(int r, int c) { const int st = (r >> 4) * 2 + (c >> 5), rr = r & 15, cc = c & 31, ob = rr * 64 + cc * 2; return st * 1024 + (ob ^ (((ob >> 9) & 1) << 5)); }
__host__ __device__ __forceinline__ void stage_rc(int b, int& R, int& C) { const int st = b / 1024, sb = b % 1024, swz = sb ^ (((sb >> 9) & 1) << 5); R = (st >> 1) * 16 + swz / 64; C = (st & 1) * 32 + (swz % 64) / 2; }
__host__ __device__ __forceinline__ int perm32(int rho) { const int n = rho >> 4, i = rho & 15; return 8 * (i >> 2) + 4 * n + (i & 3); }

struct Unit { int pm, pn; };
struct Gemm { const bf16_t* A; const bf16_t* Bt; int M, N, K; };

struct StaticOrder {
    int nM, nN, nwg, G, c;
    __host__ __device__ void init(int M, int N, int G_, int c_) { nM = M / BM; nN = N / BM; nwg = nM * nN; G = G_; c = c_; }
    __host__ __device__ bool next(int i, Unit& u) const {
        const long L = (long)i * G + c; if (L >= nwg) return false;
        int wgid = (int)L; { const int q = nwg / NXCD, r = nwg % NXCD, xcd = wgid % NXCD, off = wgid / NXCD; wgid = (xcd < r ? xcd * (q + 1) : r * (q + 1) + (xcd - r) * q) + off; }
        const int nig = WGM * nN, gid = wgid / nig, fm = gid * WGM, gsz = (nM - fm) < WGM ? (nM - fm) : WGM;
        u.pm = fm + ((wgid % nig) % gsz); u.pn = (wgid % nig) / gsz; return true;
    }
    __device__ __forceinline__ void a_ready(const Unit&) const {}
    __device__ __forceinline__ void done(const Unit&) const {}
};

__device__ __forceinline__ unsigned cvt_pk_bf16(float lo, float hi) { unsigned r; asm volatile("v_cvt_pk_bf16_f32 %0, %1, %2" : "=v"(r) : "v"(lo), "v"(hi)); return r; }
typedef float f32x2 __attribute__((ext_vector_type(2)));
__device__ __forceinline__ f32x2 gelu_pk(f32x2 v) {
    const f32x2 av = __builtin_elementwise_abs(v), d = av * 0.2316418882f + 1.0f;
    f32x2 t; t.x = __builtin_amdgcn_rcpf(d.x); t.y = __builtin_amdgcn_rcpf(d.y);
    f32x2 q = t * 0.5307027145f + (-0.7265760135f); q = q * t + 0.7107068705f; q = q * t + (-0.142248368f); q = q * t + 0.127414796f; q = q * t;
    const f32x2 s = (v * v) * (-0.72134752044f);
    f32x2 e; e.x = __builtin_amdgcn_exp2f(s.x); e.y = __builtin_amdgcn_exp2f(s.y);
    const f32x2 m = v * (q * e), r = v - m;
    f32x2 o; o.x = v.x < 0.f ? m.x : r.x; o.y = v.y < 0.f ? m.y : r.y; return o;
}

template <int ACT  > struct EpiBf16 {
    static constexpr bool PERM = true, AFTER_DRAIN = false; static_assert(ACT == 0 || ACT == 1, "EpiBf16: ACT is 0 (none) or 1 (gelu_pk)");
    bf16_t* O; int ldc; const float* bias; int split_cols; size_t split_stride; float scale0;
    __device__ __forceinline__ void operator()(const f32x4 (&acc)[2][2][4][2], const Unit& u, int wr, int wc, int fr, int fq) const {
        const int row0 = u.pm * BM + wr * 64 + fr; int colt = u.pn * BM; bf16_t* base = O;
        float sc = 1.f; if (split_cols) { const int t = colt / split_cols; base += (size_t)t * split_stride; colt -= t * split_cols; if (t == 0) sc = scale0; }
        const int col0 = colt + wc * 32 + 8 * fq, bcol0 = u.pn * BM + wc * 32 + 8 * fq;
        f32x4 bv[2][2];
#pragma unroll
        for (int bj = 0; bj < 2; ++bj)
#pragma unroll
            for (int n = 0; n < 2; ++n) bv[bj][n] = bias ? *(const f32x4*)(bias + bcol0 + bj * HALF + 4 * n) : (f32x4){0.f, 0.f, 0.f, 0.f};
#pragma unroll
        for (int ai = 0; ai < 2; ++ai)
#pragma unroll
            for (int m = 0; m < 4; ++m) { bf16_t* rowp = base + (size_t)(row0 + ai * HALF + m * 16) * ldc + col0;
#pragma unroll
                for (int bj = 0; bj < 2; ++bj) { f32x4 v0 = acc[ai][bj][m][0] + bv[bj][0], v1 = acc[ai][bj][m][1] + bv[bj][1];
                    if (ACT == 1) { f32x2 a = gelu_pk((f32x2){v0[0], v0[1]}), b = gelu_pk((f32x2){v0[2], v0[3]}), c = gelu_pk((f32x2){v1[0], v1[1]}), d = gelu_pk((f32x2){v1[2], v1[3]});
                        v0 = (f32x4){a.x, a.y, b.x, b.y}; v1 = (f32x4){c.x, c.y, d.x, d.y}; }
                    v0 = v0 * sc; v1 = v1 * sc; u32x4 w; w.x = cvt_pk_bf16(v0[0], v0[1]); w.y = cvt_pk_bf16(v0[2], v0[3]); w.z = cvt_pk_bf16(v1[0], v1[1]); w.w = cvt_pk_bf16(v1[2], v1[3]);
                    *(u32x4*)(rowp + bj * HALF) = w; } }
    }
};
__device__ __forceinline__ float fast_sigmoid(float x) { return __builtin_amdgcn_rcpf(1.0f + __builtin_amdgcn_exp2f(x * -1.4426950408889634f)); }
struct EpiSwiGLU {
    static constexpr bool PERM = true, AFTER_DRAIN = false;
    bf16_t* O; int ldc;
    __device__ __forceinline__ void operator()(const f32x4 (&acc)[2][2][4][2], const Unit& u, int wr, int wc, int fr, int fq) const {
        const int row0 = u.pm * BM + wr * 64 + fr, col0 = u.pn * HALF + wc * 32 + 8 * fq;
#pragma unroll
        for (int ai = 0; ai < 2; ++ai)
#pragma unroll
            for (int m = 0; m < 4; ++m) { bf16_t* rowp = O + (size_t)(row0 + ai * HALF + m * 16) * ldc + col0;
                float o[8];
#pragma unroll
                for (int n = 0; n < 2; ++n)
#pragma unroll
                    for (int i = 0; i < 4; ++i) { const float g = acc[ai][0][m][n][i], up = acc[ai][1][m][n][i]; o[n * 4 + i] = g * fast_sigmoid(g) * up; }
                u32x4 w; w.x = cvt_pk_bf16(o[0], o[1]); w.y = cvt_pk_bf16(o[2], o[3]); w.z = cvt_pk_bf16(o[4], o[5]); w.w = cvt_pk_bf16(o[6], o[7]);
                *(u32x4*)rowp = w; }
    }
};
struct EpiInProj {
    static constexpr bool PERM = true, AFTER_DRAIN = false;
    bf16_t* Z; size_t zstride; float qscale;
    __device__ __forceinline__ void operator()(const f32x4 (&acc)[2][2][4][2], const Unit& u, int wr, int wc, int fr, int fq) const {
        const int t = u.pn >> 1; const int row0 = u.pm * BM + wr * 64 + fr, col0 = (u.pn & 1) * BM + wc * 32 + 8 * fq;
        bf16_t* base = Z + (size_t)t * zstride; const float sc = (t == 0) ? qscale : 1.0f; const bool act = (t >= 3);
#pragma unroll
        for (int ai = 0; ai < 2; ++ai)
#pragma unroll
            for (int m = 0; m < 4; ++m) { bf16_t* rowp = base + (size_t)(row0 + ai * HALF + m * 16) * 512 + col0;
#pragma unroll
                for (int bj = 0; bj < 2; ++bj) { f32x4 v0 = acc[ai][bj][m][0], v1 = acc[ai][bj][m][1];
                    if (act) { f32x2 a = gelu_pk((f32x2){v0[0], v0[1]}), b = gelu_pk((f32x2){v0[2], v0[3]}), c = gelu_pk((f32x2){v1[0], v1[1]}), d = gelu_pk((f32x2){v1[2], v1[3]});
                        v0 = (f32x4){a.x, a.y, b.x, b.y}; v1 = (f32x4){c.x, c.y, d.x, d.y}; }
                    v0 = v0 * sc; v1 = v1 * sc; u32x4 w; w.x = cvt_pk_bf16(v0[0], v0[1]); w.y = cvt_pk_bf16(v0[2], v0[3]); w.z = cvt_pk_bf16(v1[0], v1[1]); w.w = cvt_pk_bf16(v1[2], v1[3]);
                    *(u32x4*)(rowp + bj * HALF) = w; } }
    }
};
struct EpiPleGate {
    static constexpr bool PERM = true, AFTER_DRAIN = false;
    bf16_t* O; const bf16_t* E0; int ldc;
    __device__ __forceinline__ void operator()(const f32x4 (&acc)[2][2][4][2], const Unit& u, int wr, int wc, int fr, int fq) const {
        const int row0 = u.pm * BM + wr * 64 + fr, col0 = u.pn * BM + wc * 32 + 8 * fq;
#pragma unroll
        for (int ai = 0; ai < 2; ++ai)
#pragma unroll
            for (int m = 0; m < 4; ++m) { const size_t off = (size_t)(row0 + ai * HALF + m * 16) * ldc + col0;
#pragma unroll
                for (int bj = 0; bj < 2; ++bj) { const u32x4 e = *(const u32x4*)(E0 + off + bj * HALF); const f32x4 v0 = acc[ai][bj][m][0], v1 = acc[ai][bj][m][1];
                    float o[8];
                    o[0] = fast_sigmoid(v0[0]) * __uint_as_float(e.x << 16); o[1] = fast_sigmoid(v0[1]) * __uint_as_float(e.x & 0xffff0000u);
                    o[2] = fast_sigmoid(v0[2]) * __uint_as_float(e.y << 16); o[3] = fast_sigmoid(v0[3]) * __uint_as_float(e.y & 0xffff0000u);
                    o[4] = fast_sigmoid(v1[0]) * __uint_as_float(e.z << 16); o[5] = fast_sigmoid(v1[1]) * __uint_as_float(e.z & 0xffff0000u);
                    o[6] = fast_sigmoid(v1[2]) * __uint_as_float(e.w << 16); o[7] = fast_sigmoid(v1[3]) * __uint_as_float(e.w & 0xffff0000u);
                    u32x4 w; w.x = cvt_pk_bf16(o[0], o[1]); w.y = cvt_pk_bf16(o[2], o[3]); w.z = cvt_pk_bf16(o[4], o[5]); w.w = cvt_pk_bf16(o[6], o[7]);
                    *(u32x4*)(O + off + bj * HALF) = w; } }
    }
};
template <class Epi, class Sched, bool ALIGN_EPI = false, bool SP2 = false>
__device__ __forceinline__ void gemm_phase(PG8_LAS unsigned char* lds, const Gemm g, const Sched& S, const Epi& E) {
    int tid_ = threadIdx.x; asm volatile("" : "+v"(tid_));
    const int tid = tid_, wid = __builtin_amdgcn_readfirstlane(tid >> 6), lane = tid & 63, wr = wid >> 2, wc = wid & 3, fr = lane & 15, fq = lane >> 4;
    const int K = g.K, nt = K / BK;
    unsigned voffA[2], voffB[2];
#pragma unroll
    for (int i = 0; i < 2; ++i) { int R, C; stage_rc(tid * 16 + i * 8192, R, C); const int Rb = Epi::PERM ? ((R & ~31) + perm32(R & 31)) : R;
        voffA[i] = (unsigned)(R * K + C) * 2u; voffB[i] = (unsigned)(Rb * K + C) * 2u; }
    const size_t kstep = (size_t)(BK * 2);
    const size_t hstep = (size_t)HALF * K * 2;
    const size_t tstep = 2 * hstep;
    const unsigned ldsw = (unsigned)wid * 1024u;
    const int aoff = lds_byte(wr * 64 + fr, fq * 8), boff = lds_byte(wc * 32 + fr, fq * 8);
#define PG8_SA(b, h) (((b) * 2 + (h)) * HTB)
#define PG8_SB(b, h) ((4 + (b) * 2 + (h)) * HTB)
#define PG8_STAGE(bufoff, gbase, voff) do { _Pragma("unroll") for (int _i = 0; _i < 2; ++_i) \
        __builtin_amdgcn_global_load_lds((const unsigned*)((const char*)(gbase) + (voff)[_i]), (PG8_LAS unsigned*)(lds + (bufoff) + ldsw + _i * 8192), 16, 0, 0); } while (0)
#define PG8_LDA(dst, b, h) do { _Pragma("unroll") for (int m = 0; m < 4; ++m) _Pragma("unroll") for (int k = 0; k < 2; ++k) dst[m][k] = *(const PG8_LAS bf16x8*)(lds + PG8_SA(b, h) + aoff + m * 2048 + k * 1024); } while (0)
#define PG8_LDB(dst, b, h) do { _Pragma("unroll") for (int n = 0; n < 2; ++n) _Pragma("unroll") for (int k = 0; k < 2; ++k) dst[n][k] = *(const PG8_LAS bf16x8*)(lds + PG8_SB(b, h) + boff + n * 2048 + k * 1024); } while (0)
#define PG8_MMA(ai, bj, At, Bt) do { __builtin_amdgcn_s_setprio(1); _Pragma("unroll") for (int m = 0; m < 4; ++m) _Pragma("unroll") for (int n = 0; n < 2; ++n) _Pragma("unroll") for (int k = 0; k < 2; ++k) \
        acc[ai][bj][m][n] = __builtin_amdgcn_mfma_f32_16x16x32_bf16(Bt[n][k], At[m][k], acc[ai][bj][m][n], 0, 0, 0); __builtin_amdgcn_s_setprio(0); } while (0)
#define PG8_WAIT_V(n) asm volatile("s_waitcnt vmcnt(" #n ")" ::: "memory")
#define PG8_WAIT_L(n) asm volatile("s_waitcnt lgkmcnt(" #n ")" ::: "memory")
#define PG8_BAR __builtin_amdgcn_s_barrier()
#define PG8_SCHED __builtin_amdgcn_sched_barrier(0)
    Unit cur, nxt; int ui = 0;
    if (!S.next(0, cur)) return;
    f32x4 acc[2][2][4][2];
#pragma unroll
    for (int a = 0; a < 2; ++a)
#pragma unroll
        for (int b = 0; b < 2; ++b)
#pragma unroll
            for (int m = 0; m < 4; ++m)
#pragma unroll
                for (int n = 0; n < 2; ++n) acc[a][b][m][n] = (f32x4){0.f, 0.f, 0.f, 0.f};
    bf16x8 At[4][2], B0[2][2], B1[2][2];
    const char* cA = (const char*)g.A + (size_t)cur.pm * tstep; const char* cB = (const char*)g.Bt + (size_t)cur.pn * tstep;
    S.a_ready(cur);
    if constexpr (SP2) {
        PG8_STAGE(PG8_SB(0, 0), cB, voffB); PG8_STAGE(PG8_SB(0, 1), cB + hstep, voffB); PG8_STAGE(PG8_SA(0, 0), cA, voffA); PG8_STAGE(PG8_SA(0, 1), cA + hstep, voffA);
        if (wr == 1) PG8_BAR;
        PG8_WAIT_V(2); PG8_BAR;
        PG8_STAGE(PG8_SB(1, 0), cB + kstep, voffB); PG8_STAGE(PG8_SA(1, 0), cA + kstep, voffA); PG8_STAGE(PG8_SB(1, 1), cB + hstep + kstep, voffB);
        PG8_WAIT_V(6); PG8_BAR;
    } else {
        PG8_STAGE(PG8_SB(0, 0), cB, voffB); PG8_STAGE(PG8_SA(0, 0), cA, voffA); PG8_STAGE(PG8_SB(0, 1), cB + hstep, voffB); PG8_STAGE(PG8_SA(0, 1), cA + hstep, voffA);
        if (wr == 1) PG8_BAR;
        PG8_WAIT_V(4); PG8_BAR;
        PG8_STAGE(PG8_SB(1, 0), cB + kstep, voffB); PG8_STAGE(PG8_SA(1, 0), cA + kstep, voffA); PG8_STAGE(PG8_SB(1, 1), cB + hstep + kstep, voffB);
        PG8_WAIT_V(6); PG8_BAR;
    }
    for (;;) {
        const bool has_next = S.next(ui + 1, nxt);
        const char* nA = has_next ? (const char*)g.A + (size_t)nxt.pm * tstep : cA; const char* nB = has_next ? (const char*)g.Bt + (size_t)nxt.pn * tstep : cB;
        for (int t = 0; t < nt; t += 2) {
            const bool last = (t == nt - 2);
            const char* a1 = cA + (size_t)(t + 1) * kstep;
            const char* a2 = last ? nA : cA + (size_t)(t + 2) * kstep; const char* b2 = last ? nB : cB + (size_t)(t + 2) * kstep;
            const char* a3 = a2 + kstep; const char* b3 = b2 + kstep;
            if (last && has_next) S.a_ready(nxt);
            if constexpr (SP2) {
            PG8_LDB(B0, 0, 0); PG8_LDB(B1, 0, 1); PG8_SCHED; PG8_LDA(At, 0, 0); PG8_STAGE(PG8_SA(1, 1), a1 + hstep, voffA);
            PG8_WAIT_V(8); PG8_WAIT_L(0); PG8_BAR; PG8_MMA(0, 0, At, B0); PG8_MMA(0, 1, At, B1); PG8_BAR; PG8_SCHED;
            PG8_LDA(At, 0, 1); PG8_STAGE(PG8_SB(0, 0), b2, voffB); PG8_STAGE(PG8_SB(0, 1), b2 + hstep, voffB); PG8_STAGE(PG8_SA(0, 0), a2, voffA);
            PG8_WAIT_V(8); PG8_WAIT_L(0); PG8_BAR; PG8_MMA(1, 0, At, B0); PG8_MMA(1, 1, At, B1); PG8_BAR; PG8_SCHED;
            PG8_LDB(B0, 1, 0); PG8_LDB(B1, 1, 1); PG8_SCHED; PG8_LDA(At, 1, 0); PG8_STAGE(PG8_SA(0, 1), a2 + hstep, voffA);
            PG8_WAIT_V(8); PG8_WAIT_L(0); PG8_BAR; PG8_MMA(0, 0, At, B0); PG8_MMA(0, 1, At, B1); PG8_BAR; PG8_SCHED;
            PG8_LDA(At, 1, 1); PG8_STAGE(PG8_SB(1, 0), b3, voffB); PG8_STAGE(PG8_SB(1, 1), b3 + hstep, voffB); PG8_STAGE(PG8_SA(1, 0), a3, voffA);
            PG8_WAIT_V(8); PG8_WAIT_L(0); PG8_BAR; PG8_MMA(1, 0, At, B0); PG8_MMA(1, 1, At, B1); PG8_BAR; PG8_SCHED;
            } else {
            PG8_LDB(B0, 0, 0); PG8_SCHED; PG8_LDA(At, 0, 0); PG8_STAGE(PG8_SA(1, 1), a1 + hstep, voffA);
            PG8_WAIT_L(8); PG8_BAR; PG8_WAIT_L(0); PG8_MMA(0, 0, At, B0); PG8_BAR; PG8_SCHED;
            PG8_LDB(B1, 0, 1); PG8_STAGE(PG8_SB(0, 0), b2, voffB);
            PG8_BAR; PG8_WAIT_L(0); PG8_MMA(0, 1, At, B1); PG8_BAR;
            PG8_LDA(At, 0, 1); PG8_STAGE(PG8_SA(0, 0), a2, voffA);
            PG8_BAR; PG8_WAIT_L(0); PG8_MMA(1, 0, At, B0); PG8_BAR; PG8_SCHED;
            PG8_STAGE(PG8_SB(0, 1), b2 + hstep, voffB);
            PG8_WAIT_V(6); PG8_BAR; PG8_MMA(1, 1, At, B1); PG8_BAR;
            PG8_LDB(B0, 1, 0); PG8_SCHED; PG8_LDA(At, 1, 0); PG8_STAGE(PG8_SA(0, 1), a2 + hstep, voffA);
            PG8_WAIT_L(8); PG8_BAR; PG8_WAIT_L(0); PG8_MMA(0, 0, At, B0); PG8_BAR; PG8_SCHED;
            PG8_LDB(B1, 1, 1); PG8_STAGE(PG8_SB(1, 0), b3, voffB);
            PG8_BAR; PG8_WAIT_L(0); PG8_MMA(0, 1, At, B1); PG8_BAR;
            PG8_LDA(At, 1, 1); PG8_STAGE(PG8_SA(1, 0), a3, voffA);
            PG8_BAR; PG8_WAIT_L(0); PG8_MMA(1, 0, At, B0); PG8_BAR; PG8_SCHED;
            PG8_STAGE(PG8_SB(1, 1), b3 + hstep, voffB);
            PG8_WAIT_V(6); PG8_BAR; PG8_MMA(1, 1, At, B1); PG8_BAR;
            }
        }
        if constexpr (ALIGN_EPI) { if (wr == 0) PG8_BAR; }
        if constexpr (!Epi::AFTER_DRAIN) { E(acc, cur, wr, wc, fr, fq); S.done(cur); }
        if (!has_next) break;
#pragma unroll
        for (int a = 0; a < 2; ++a)
#pragma unroll
            for (int b = 0; b < 2; ++b)
#pragma unroll
                for (int m = 0; m < 4; ++m)
#pragma unroll
                    for (int n = 0; n < 2; ++n) acc[a][b][m][n] = (f32x4){0.f, 0.f, 0.f, 0.f};
        cur = nxt; cA = nA; cB = nB; ++ui;
        if constexpr (ALIGN_EPI) { if (wr == 1) PG8_BAR; }
    }
    PG8_WAIT_V(0);
    if constexpr (!ALIGN_EPI) { if (wr == 0) PG8_BAR; }
    PG8_BAR;
    if constexpr (Epi::AFTER_DRAIN) { E.fused(acc, cur, wr, wc, fr, fq, lds, wid, lane); S.done(cur); }
#undef PG8_SA
#undef PG8_SB
#undef PG8_STAGE
#undef PG8_LDA
#undef PG8_LDB
#undef PG8_MMA
#undef PG8_WAIT_V
#undef PG8_WAIT_L
#undef PG8_BAR
#undef PG8_SCHED
}
}
#include <hip/hip_bf16.h>
#include <cmath>
namespace attn_body {
using bf16=__hip_bfloat16;
using bf16x8=__attribute__((ext_vector_type(8)))short;
using s16x4=__attribute__((ext_vector_type(4)))short;
using f32x16=__attribute__((ext_vector_type(16)))float;
using u32x4=__attribute__((ext_vector_type(4)))unsigned;
constexpr int BATCH=16,NHEAD=8,SEQ=2048,D=64,PQ=512,PO=1024;
constexpr int NW=8,QBLK=32,QB=QBLK*NW,KVBLK=64,NQB=SEQ/QB;
__device__ __forceinline__ int crow(int r,int hi){return (r&3)+8*(r>>2)+4*hi;}
#define SBAR() __builtin_amdgcn_sched_barrier(0)
__device__ __forceinline__ void cmask(f32x16&p0,f32x16&p1,int jb,int qrel,int hi){
  const float NEG=-INFINITY; int kb=64*jb+4*hi;
  #pragma unroll
  for(int r=0;r<16;++r){int kv=kb+(r&3)+8*(r>>2); if(kv>qrel)p0[r]=NEG; if(kv+32>qrel)p1[r]=NEG;}
}

constexpr int NSLOT=3, SLOTB=8192;
constexpr int LDS_K=0, LDS_V=NSLOT*SLOTB, LDS_WS=2*NSLOT*SLOTB, LDS_OST=LDS_WS+NW*64*4, LDS_BYTES=LDS_OST+NW*4096;
constexpr float C2=0.125f*1.4426950408889634f;
__device__ __forceinline__ void glds16(const void*gsrc,unsigned lds_dst){unsigned keep;
  asm volatile("s_mov_b32 %0, m0\n\ts_mov_b32 m0, %2\n\ts_nop 0\n\tglobal_load_lds_dwordx4 %1, off\n\ts_mov_b32 m0, %0":"=&s"(keep):"v"(gsrc),"s"(lds_dst):"memory");}
__device__ __forceinline__ float max3f(float a,float b,float c){float r;asm("v_max3_f32 %0, %1, %2, %3":"=v"(r):"v"(a),"v"(b),"v"(c));return r;}
__device__ __forceinline__ float max2f(float a,float b){float r;asm("v_max_f32_e32 %0, %1, %2":"=v"(r):"v"(a),"v"(b));return r;}
__device__ __forceinline__ float fadd_s(float a,float b){float r;asm("v_add_f32_e32 %0, %1, %2":"=v"(r):"v"(a),"v"(b));return r;}
__device__ __forceinline__ float fsub_s(float a,float b){float r;asm("v_sub_f32_e32 %0, %1, %2":"=v"(r):"v"(a),"v"(b));return r;}
typedef float f32x4g __attribute__((ext_vector_type(4)));
__device__ __forceinline__ float bfv(short v){return __uint_as_float(((unsigned)(unsigned short)v)<<16);}
typedef float f32x2_t __attribute__((ext_vector_type(2))); typedef __bf16 bf16x2_t __attribute__((ext_vector_type(2)));
__device__ __forceinline__ unsigned cvtpk_s(float lo,float hi){f32x2_t v={lo,hi};bf16x2_t b=__builtin_convertvector(v,bf16x2_t);return __builtin_bit_cast(unsigned,b);}
#define WAIT_BAR(N) asm volatile("s_waitcnt vmcnt(" #N ") lgkmcnt(0)\n\ts_barrier":::"memory")

__device__ __forceinline__ void qkt(f32x16&p0,f32x16&p1,const char*Kslot,const bf16x8*qr,int r32,int hi){
  const char*kb=Kslot+hi*1024+r32*16;
  #pragma unroll
  for(int d0=0;d0<4;++d0){
    const bf16x8 b0=*reinterpret_cast<const bf16x8*>(kb+d0*2048);
    const bf16x8 b1=*reinterpret_cast<const bf16x8*>(kb+d0*2048+512);
    p0=__builtin_amdgcn_mfma_f32_32x32x16_bf16(b0,qr[d0],p0,0,0,0);p1=__builtin_amdgcn_mfma_f32_32x32x16_bf16(b1,qr[d0],p1,0,0,0);}
}
typedef __attribute__((address_space(3))) const char* lds_cptr;
typedef short v4i16_t __attribute__((ext_vector_type(4)));
__device__ __forceinline__ void kload8(bf16x8*kf,lds_cptr kp){
  kf[0]=*(const __attribute__((address_space(3))) bf16x8*)(kp);      kf[1]=*(const __attribute__((address_space(3))) bf16x8*)(kp+512);
  kf[2]=*(const __attribute__((address_space(3))) bf16x8*)(kp+2048); kf[3]=*(const __attribute__((address_space(3))) bf16x8*)(kp+2560);
  kf[4]=*(const __attribute__((address_space(3))) bf16x8*)(kp+4096); kf[5]=*(const __attribute__((address_space(3))) bf16x8*)(kp+4608);
  kf[6]=*(const __attribute__((address_space(3))) bf16x8*)(kp+6144); kf[7]=*(const __attribute__((address_space(3))) bf16x8*)(kp+6656);
}
__device__ __forceinline__ void kload2(bf16x8*kf,lds_cptr kp,int j){ kf[2*j]=*(const __attribute__((address_space(3))) bf16x8*)(kp+j*2048); kf[2*j+1]=*(const __attribute__((address_space(3))) bf16x8*)(kp+j*2048+512); }
__device__ __forceinline__ s16x4 vtr(lds_cptr p){ return __builtin_bit_cast(s16x4,__builtin_amdgcn_ds_read_tr16_b64_v4i16((__attribute__((address_space(3))) v4i16_t*)p)); }
__device__ __forceinline__ float rowmax(const f32x16&p0,const f32x16&p1){
  float a=max3f(p0[0],p0[1],p1[0]),b=max3f(p0[2],p0[3],p1[1]);a=max3f(a,p1[2],p1[3]);
  #pragma unroll
  for(int r=4;r<16;r+=4){a=max3f(a,p0[r],p0[r+1]);b=max3f(b,p0[r+2],p0[r+3]);a=max3f(a,p1[r],p1[r+1]);b=max3f(b,p1[r+2],p1[r+3]);}
  const float m=max2f(a,b);
  auto rr=__builtin_amdgcn_permlane32_swap(__float_as_uint(m),__float_as_uint(m),false,false);
  return max2f(__uint_as_float(rr[0]),__uint_as_float(rr[1]));
}
__device__ __forceinline__ void pv(f32x16*o,int vb,bf16x8 pa0,bf16x8 pa1,bf16x8 pa2,bf16x8 pa3){
  #pragma unroll
  for(int d0=0;d0<2;++d0){s16x4 lo[4],hi[4];
    #pragma unroll
    for(int ks=0;ks<4;++ks){
      asm volatile("ds_read_b64_tr_b16 %0,%1 offset:%c2":"=&v"(lo[ks]):"v"(vb),"i"(d0*4096+ks*1024):"memory");
      asm volatile("ds_read_b64_tr_b16 %0,%1 offset:%c2":"=&v"(hi[ks]):"v"(vb),"i"(d0*4096+ks*1024+512):"memory");}
    asm volatile("s_waitcnt lgkmcnt(0)":::"memory");SBAR();
    #define PK(k) (bf16x8){lo[k][0],lo[k][1],lo[k][2],lo[k][3],hi[k][0],hi[k][1],hi[k][2],hi[k][3]}
    o[d0]=__builtin_amdgcn_mfma_f32_32x32x16_bf16(pa0,PK(0),o[d0],0,0,0);
    o[d0]=__builtin_amdgcn_mfma_f32_32x32x16_bf16(pa1,PK(1),o[d0],0,0,0);
    o[d0]=__builtin_amdgcn_mfma_f32_32x32x16_bf16(pa2,PK(2),o[d0],0,0,0);
    o[d0]=__builtin_amdgcn_mfma_f32_32x32x16_bf16(pa3,PK(3),o[d0],0,0,0);
    #undef PK
  }
}

#ifndef ATTN_STORE16
#define ATTN_STORE16(p,v) (*(u32x4*)(p)=(v))
#endif
template<int THRL> __device__ __forceinline__ void attn_unit(int b,int h,int qb,const bf16*Q,const bf16*__restrict__ K,const bf16*__restrict__ V,bf16*O,float*SSQ,const float*__restrict__ KM,char*shm){
  int tid_=threadIdx.x; asm volatile("":"+v"(tid_)); const int tid=tid_,lane=tid&63,r32=lane&31,hi=lane>>5; const int wid=__builtin_amdgcn_readfirstlane(tid>>6);
  const long rowbase=(long)b*SEQ; const int q0=qb*QB;
  const bf16*Qw=Q+(rowbase+q0+wid*QBLK)*PQ+h*D;
  const bf16*Kh=K+rowbase*PQ+h*D,*Vh=V+rowbase*PQ+h*D;
  const unsigned lds0=(unsigned)(uintptr_t)shm;
  float*wsf=(float*)(shm+LDS_WS)+wid*64;
  const bf16*ksrc=Kh+(long)lane*PQ+wid*8;
  const bf16*vsrc=Vh+(long)(16*(wid&3)+(lane>>2))*PQ+(wid>>2)*32+(lane&3)*8;
  const unsigned kdst=lds0+LDS_K+wid*1024, vdst=lds0+LDS_V+wid*1024;
  #define KT(t) (((t)<4)?(4*qb+(t)):((t)-4))
  #define DMA_K(t,slot) glds16(ksrc+(long)KT(t)*KVBLK*PQ,(unsigned)__builtin_amdgcn_readfirstlane(kdst+(slot)))
  #define DMA_V(t,slot) glds16(vsrc+(long)KT(t)*KVBLK*PQ,(unsigned)__builtin_amdgcn_readfirstlane(vdst+(slot)))
  const int vb0=(int)(lds0+LDS_V)+((lane>>4)&1)*32+(lane&3)*8+(4*hi+((lane&15)>>2))*64;
  const char*Kbase=shm+LDS_K; bf16x8 kf[8];
  const lds_cptr shm3=(lds_cptr)shm; const lds_cptr kp0=shm3+LDS_K+hi*1024+r32*16; const lds_cptr vp0=shm3+LDS_V+((lane>>4)&1)*32+(lane&3)*8+(4*hi+((lane&15)>>2))*64;
  const int NT=(q0+QB)/KVBLK;
  DMA_K(0,0);DMA_V(0,0);DMA_K(1,SLOTB);
  bf16x8 qr[4];
  #pragma unroll
  for(int d0=0;d0<4;++d0)qr[d0]=*reinterpret_cast<const bf16x8*>(&Qw[(long)r32*PQ+d0*16+hi*8]);
  unsigned selm=0u;
  if(qb>0){ float gsc[7];
    #pragma unroll
    for(int n=0;n<7;++n){ float a=0.f;
      if(n<qb){ const float*km=KM+((long)((b*NHEAD+h)*NQB+n))*D+8*hi;
        #pragma unroll
        for(int d0=0;d0<4;++d0){ const f32x4g k0=*(const f32x4g*)(km+16*d0), k1=*(const f32x4g*)(km+16*d0+4);
          a+=bfv(qr[d0][0])*k0[0]+bfv(qr[d0][1])*k0[1]+bfv(qr[d0][2])*k0[2]+bfv(qr[d0][3])*k0[3]+bfv(qr[d0][4])*k1[0]+bfv(qr[d0][5])*k1[1]+bfv(qr[d0][6])*k1[2]+bfv(qr[d0][7])*k1[3]; } }
      a+=__shfl_xor(a,32); gsc[n]=(n<qb)?a:-INFINITY; }
    #pragma unroll
    for(int k=0;k<3;++k){ int best=-1; float bv=-INFINITY;
      #pragma unroll
      for(int n=0;n<7;++n) if(!((selm>>n)&1u)&&gsc[n]>bv){bv=gsc[n];best=n;}
      if(best>=0)selm|=1u<<best; } }
  const float sl2=__builtin_amdgcn_exp2f(-(float)(h+1))*1.4426950408889634f, sl32=32.f*sl2, cbase=(float)(4*hi)*sl2;
  float mhat=0.f,l_reg=0.f;f32x16 o[2];o[0]=f32x16{};o[1]=f32x16{};
  #define CIN(C0,C1,t) do{ float cl_=cbase+(float)(KT(t)*KVBLK-q0)*sl2-mhat; if((t)>=4){ if(!((selm>>(((t)>=4?(t)-4:0)>>2))&1u)) cl_=-INFINITY; } const float cl1_=cl_+sl32; \
    _Pragma("unroll") for(int r=0;r<16;++r){C0[r]=__builtin_fmaf(sl2,(float)((r&3)+8*(r>>2)),cl_);C1[r]=__builtin_fmaf(sl2,(float)((r&3)+8*(r>>2)),cl1_);} }while(0)
  const int qrel=wid*QBLK+r32;
  #define CMASK(P0,P1,t) do{ if((t)<4)cmask(P0,P1,(t),qrel,hi); }while(0)
  bool resc=false;
  #define START(P0,P1) do{ const float rm=rowmax(P0,P1); resc=false; \
    { const float dl=rm; mhat=fadd_s(mhat,dl); \
      _Pragma("unroll") for(int r=0;r<16;++r){P0[r]=fsub_s(P0[r],dl);P1[r]=fsub_s(P1[r],dl);} } \
    _Pragma("unroll") for(int r=0;r<16;++r)P0[r]=__builtin_amdgcn_exp2f(P0[r]); }while(0)
  #define RESC() do{ if(resc){ asm volatile("s_waitcnt lgkmcnt(0)":::"memory"); \
      _Pragma("unroll") for(int d_=0;d_<2;++d_) _Pragma("unroll") for(int r=0;r<16;++r)o[d_][r]*=wsf[crow(r,hi)]; } }while(0)
  f32x16 pA0,pA1,pB0,pB1;
  int sl_prev=0,sl_cur=0,sl_next=SLOTB;
  #define ROT() do{sl_prev=sl_cur;sl_cur=sl_next;sl_next=(sl_next==(NSLOT-1)*SLOTB)?0:sl_next+SLOTB;}while(0)
  DMA_K(2,2*SLOTB);
  WAIT_BAR(3);
  CIN(pA0,pA1,0); qkt(pA0,pA1,Kbase,qr,r32,hi);asm volatile("s_nop 15\n\ts_nop 7":"+v"(pA0),"+v"(pA1));CMASK(pA0,pA1,0);
  START(pA0,pA1);
  _Pragma("unroll") for(int r=0;r<16;++r)pA1[r]=__builtin_amdgcn_exp2f(pA1[r]);
  WAIT_BAR(0);
  DMA_K(3,0);DMA_V(1,SLOTB);
  ROT();
  kload8(kf,kp0+sl_cur);
  WAIT_BAR(2);
  s16x4 vlo[8],vhi[8]; u32x4 pw0,pw1,pw2,pw3;
  #define PKW(P,B) cvtpk_s(P[B],P[B+1])
  #define PAF(k) __builtin_bit_cast(bf16x8,pw##k)
  #define VFR(i) (bf16x8){vlo[i][0],vlo[i][1],vlo[i][2],vlo[i][3],vhi[i][0],vhi[i][1],vhi[i][2],vhi[i][3]}
  #define PIN(x) asm volatile("":"+v"(x))
  #define MX3(a,b,c) __builtin_fmaxf(__builtin_fmaxf((a),(b)),(c))
  #define GAPA(MF,A0,A1,A2,A3,W0,W1,PW) do{ MF; sacc+=A0; sacc+=A1; sacc+=A2; sacc+=A3; PIN(sacc); W0; W1; PIN(PW); SBAR(); }while(0)
  #define EX(v) __builtin_amdgcn_exp2f(v)
  #define GAPB(MF,X,B) do{ MF; X[B]=EX(X[B]); X[B+1]=EX(X[B+1]); X[B+2]=EX(X[B+2]); X[B+3]=EX(X[B+3]); PIN(X); SBAR(); }while(0)
  #define VRD(i) do{ vlo[i]=vtr(vp_+(((i)>>2)*4096+((i)&3)*1024)); vhi[i]=vtr(vp_+(((i)>>2)*4096+((i)&3)*1024+512)); }while(0)
  #define KRD(G,j) do{ if(G){ kload2(kf,kp0+sl_next,j); SBAR(); } }while(0)
  #define STEP(C0,C1,P0,P1,t,GK,GV,GL) do{ SBAR(); CIN(C0,C1,t); SBAR(); \
    const lds_cptr vp_=vp0+sl_prev; \
    VRD(0); SBAR(); float sacc=(P0[0]+P0[1]); \
    GAPA(C0=__builtin_amdgcn_mfma_f32_32x32x16_bf16(kf[0],qr[0],C0,0,0,0), P0[2],P0[3],P0[4],P0[5],     pw0[0]=PKW(P0,0), pw0[1]=PKW(P0,2), pw0); \
    VRD(4); SBAR(); GAPA(C1=__builtin_amdgcn_mfma_f32_32x32x16_bf16(kf[1],qr[0],C1,0,0,0), P0[6],P0[7],P0[8],P0[9],     pw0[2]=PKW(P0,4), pw0[3]=PKW(P0,6), pw0); \
    VRD(1); SBAR(); GAPA(C0=__builtin_amdgcn_mfma_f32_32x32x16_bf16(kf[2],qr[1],C0,0,0,0),   P0[10],P0[11],P0[12],P0[13], pw1[0]=PKW(P0,8), pw1[1]=PKW(P0,10), pw1); \
    VRD(5); SBAR(); GAPA(C1=__builtin_amdgcn_mfma_f32_32x32x16_bf16(kf[3],qr[1],C1,0,0,0),   P0[14],P0[15],P1[0],P1[1],   pw1[2]=PKW(P0,12),pw1[3]=PKW(P0,14), pw1); \
    VRD(2); SBAR(); GAPA(C0=__builtin_amdgcn_mfma_f32_32x32x16_bf16(kf[4],qr[2],C0,0,0,0),   P1[2],P1[3],P1[4],P1[5],     pw2[0]=PKW(P1,0), pw2[1]=PKW(P1,2), pw2); \
    VRD(6); SBAR(); GAPA(C1=__builtin_amdgcn_mfma_f32_32x32x16_bf16(kf[5],qr[2],C1,0,0,0),   P1[6],P1[7],P1[8],P1[9],     pw2[2]=PKW(P1,4), pw2[3]=PKW(P1,6), pw2); \
    VRD(3); SBAR(); GAPA(C0=__builtin_amdgcn_mfma_f32_32x32x16_bf16(kf[6],qr[3],C0,0,0,0),   P1[10],P1[11],P1[12],P1[13], pw3[0]=PKW(P1,8), pw3[1]=PKW(P1,10), pw3); \
    VRD(7); SBAR(); GAPA(C1=__builtin_amdgcn_mfma_f32_32x32x16_bf16(kf[7],qr[3],C1,0,0,0),   P1[14],P1[15],0.f,0.f,       pw3[2]=PKW(P1,12),pw3[3]=PKW(P1,14), pw3); \
    l_reg+=sacc; \
    if(GK){DMA_K((t)+3,sl_cur);} if(GV){DMA_V((t)+1,sl_next);} \
    CMASK(C0,C1,t); \
    { float a=MX3(C0[0],C0[1],C1[0]),b=MX3(C0[2],C0[3],C1[1]); a=MX3(a,C1[2],C1[3]); \
      _Pragma("unroll") for(int r=4;r<16;r+=4){a=MX3(a,C0[r],C0[r+1]);b=MX3(b,C0[r+2],C0[r+3]);a=MX3(a,C1[r],C1[r+1]);b=MX3(b,C1[r+2],C1[r+3]);} \
      float rm=__builtin_fmaxf(a,b); { auto rr=__builtin_amdgcn_permlane32_swap(__float_as_uint(rm),__float_as_uint(rm),false,false); rm=__builtin_fmaxf(__uint_as_float(rr[0]),__uint_as_float(rr[1])); } \
      resc=false; \
      if(__builtin_expect(__any(rm>(float)THRL),0)){ const float dl=__builtin_fmaxf(rm,0.f); mhat+=dl; \
        _Pragma("unroll") for(int r=0;r<16;++r){C0[r]-=dl;C1[r]-=dl;} \
        const float f=__builtin_amdgcn_exp2f(-dl); l_reg*=f; if(hi==0)wsf[r32]=f; resc=true; } } \
    SBAR(); \
    GAPB(o[0]=__builtin_amdgcn_mfma_f32_32x32x16_bf16(PAF(0),VFR(0),o[0],0,0,0), C0,0); \
    GAPB(o[1]=__builtin_amdgcn_mfma_f32_32x32x16_bf16(PAF(0),VFR(4),o[1],0,0,0), C0,4); \
    KRD(GL,0); GAPB(o[0]=__builtin_amdgcn_mfma_f32_32x32x16_bf16(PAF(1),VFR(1),o[0],0,0,0), C0,8); \
    KRD(GL,1); GAPB(o[1]=__builtin_amdgcn_mfma_f32_32x32x16_bf16(PAF(1),VFR(5),o[1],0,0,0), C0,12); \
    KRD(GL,2); GAPB(o[0]=__builtin_amdgcn_mfma_f32_32x32x16_bf16(PAF(2),VFR(2),o[0],0,0,0), C1,0); \
    KRD(GL,3); GAPB(o[1]=__builtin_amdgcn_mfma_f32_32x32x16_bf16(PAF(2),VFR(6),o[1],0,0,0), C1,4); \
    GAPB(o[0]=__builtin_amdgcn_mfma_f32_32x32x16_bf16(PAF(3),VFR(3),o[0],0,0,0), C1,8); \
    GAPB(o[1]=__builtin_amdgcn_mfma_f32_32x32x16_bf16(PAF(3),VFR(7),o[1],0,0,0), C1,12); \
    }while(0)
  int t=1;
  #define ENDW(tt) do{ if((tt)+3<NT){WAIT_BAR(2);} else if((tt)+2<NT){WAIT_BAR(1);} else {WAIT_BAR(0);} }while(0)
  for(;t+1<NT;t+=2){
    STEP(pB0,pB1,pA0,pA1,t,(t+3<NT),(t+1<NT),(t+1<NT));       ENDW(t);   RESC(); ROT();
    STEP(pA0,pA1,pB0,pB1,t+1,(t+4<NT),(t+2<NT),(t+2<NT));     ENDW(t+1); RESC(); ROT();
  }
  STEP(pB0,pB1,pA0,pA1,NT-1,false,false,false); RESC();
  { float sacc=pB0[0]+pB0[1]; _Pragma("unroll") for(int r=2;r<16;++r)sacc+=pB0[r]; _Pragma("unroll") for(int r=0;r<16;++r)sacc+=pB1[r]; l_reg+=sacc;
    pw0=(u32x4){PKW(pB0,0),PKW(pB0,2),PKW(pB0,4),PKW(pB0,6)};pw1=(u32x4){PKW(pB0,8),PKW(pB0,10),PKW(pB0,12),PKW(pB0,14)};pw2=(u32x4){PKW(pB1,0),PKW(pB1,2),PKW(pB1,4),PKW(pB1,6)};pw3=(u32x4){PKW(pB1,8),PKW(pB1,10),PKW(pB1,12),PKW(pB1,14)};
    SBAR(); pv(o,vb0+sl_cur,PAF(0),PAF(1),PAF(2),PAF(3)); }
  #undef PKW
  #undef PAF
  #undef VFR
  #undef PIN
  #undef MX3
  #undef GAPA
  #undef GAPB
  #undef EX
  #undef VRD
  #undef KRD
  #undef STEP
  #undef ENDW
  {auto rr=__builtin_amdgcn_permlane32_swap(__float_as_uint(l_reg),__float_as_uint(l_reg),false,false);l_reg=__uint_as_float(rr[0])+__uint_as_float(rr[1]);}
  if(hi==0)wsf[32+r32]=l_reg;asm volatile("s_waitcnt lgkmcnt(0)":::"memory");
  float rli[16];
  #pragma unroll
  for(int r=0;r<16;++r)rli[r]=__builtin_amdgcn_rcpf(wsf[32+crow(r,hi)]);
  bf16*Ow=O+(rowbase+q0+wid*QBLK)*PO+h*D; float*Sw=SSQ+(rowbase+q0+wid*QBLK)*NHEAD+h;
  { bf16*stg=(bf16*)(shm+LDS_OST)+wid*2048;
    #pragma unroll
    for(int r=0;r<16;++r){const int orow=crow(r,hi);
      #pragma unroll
      for(int d0=0;d0<2;++d0)stg[orow*64+d0*32+r32]=__float2bfloat16(o[d0][r]*rli[r]);}
    asm volatile("s_waitcnt lgkmcnt(0)":::"memory");
    #pragma unroll
    for(int i=0;i<4;++i){const int row=i*8+(lane>>3),ch=lane&7; const u32x4 v=*(const u32x4*)(stg+row*64+ch*8); ATTN_STORE16(Ow+(long)row*PO+ch*8,v);
      float ss=0.f;
      #pragma unroll
      for(int k=0;k<4;++k){const float lo=__uint_as_float(v[k]<<16),hh=__uint_as_float(v[k]&0xffff0000u); ss+=lo*lo+hh*hh;}
      ss+=__shfl_xor(ss,1);ss+=__shfl_xor(ss,2);ss+=__shfl_xor(ss,4); if(ch==0)Sw[(long)row*NHEAD]=ss;} }
  asm volatile("s_waitcnt lgkmcnt(0)\n\ts_barrier":::"memory");
  #undef DMA_K
  #undef KT
  #undef CIN
  #undef DMA_V
  #undef CMASK
  #undef START
  #undef RESC
  #undef ROT
}
constexpr int ATTN_LDS_BYTES=LDS_BYTES;
struct AttnTensors { const bf16* Q; const bf16* K; const bf16* V; bf16* O; float* SSQ; const float* KM; };
struct AttnUnit { int bh; int qb; };
struct MobaOrder {
  int vcu,G;
  __device__ __forceinline__ explicit MobaOrder(int grid,int block):vcu((grid%8==0)?(block%8)*(grid/8)+block/8:block),G(grid){}
  __device__ __forceinline__ bool next(int i,AttnUnit&u)const{ const int L=(i>>2)*G+vcu; if(L>=BATCH*NHEAD*2)return false; const int s=2*(L&1)+((i>>1)&1); u.bh=L>>1; u.qb=(i&1)?7-s:s; return true; }
};
template<class Sched,int THRL=8> __device__ __forceinline__ void attn_phase(char*lds,const AttnTensors&T,const Sched&S){
  AttnUnit u;
  for(int i=0;S.next(i,u);++i){ attn_unit<THRL>(u.bh/NHEAD,u.bh%NHEAD,u.qb,T.Q,T.K,T.V,T.O,T.SSQ,T.KM,lds); }
}
#undef SBAR
#undef WAIT_BAR
}
#define GAS __attribute__((address_space(1)))
#define LAS __attribute__((address_space(3)))
typedef unsigned short bf16;
typedef unsigned v4u __attribute__((ext_vector_type(4)));
typedef float f32x4 __attribute__((ext_vector_type(4)));
typedef short bf16x8 __attribute__((ext_vector_type(8)));
typedef GAS unsigned gu32;
typedef GAS unsigned long long gu64;
#define RLX_AGENT __ATOMIC_RELAXED, __HIP_MEMORY_SCOPE_AGENT
#define LDS_WAIT() asm volatile("s_waitcnt lgkmcnt(0)" ::: "memory")
#define VM_WAIT() asm volatile("s_waitcnt vmcnt(0)" ::: "memory")
__device__ __forceinline__ unsigned long long rt() { return __builtin_amdgcn_s_memrealtime(); }
__device__ __forceinline__ unsigned f2bf(float f) { unsigned u = __builtin_bit_cast(unsigned, f); return (u + 0x7fffu + ((u >> 16) & 1u)) >> 16; }
__device__ __forceinline__ unsigned pk2(float lo, float hi) { return f2bf(lo) | (f2bf(hi) << 16); }

#define XB_TMO      128
#define XB_XCNT(j)  (256  + 64 * (j))
#define XB_XSUB(j)  (1280 + 64 * (j))
#define XB_XGEN(j)  (2304 + 64 * (j))
#define XB_TOP      3328
#define XB_TOPGEN   3392
#define XCD_BAR_WORDS 3456
#define XB_SPIN_CAP (1u << 18)

__device__ __forceinline__ unsigned xb_ld(unsigned* p)              { return __hip_atomic_load(p, __ATOMIC_RELAXED, __HIP_MEMORY_SCOPE_AGENT); }
__device__ __forceinline__ unsigned xb_add(unsigned* p, unsigned v) { return __hip_atomic_fetch_add(p, v, __ATOMIC_RELAXED, __HIP_MEMORY_SCOPE_AGENT); }
__device__ __forceinline__ unsigned xb_xcc_id() { return (unsigned)__builtin_amdgcn_s_getreg((3 << 11) | 20) & 0xFu; }
#define XB_SPIN(cond, bar) do { unsigned _sp = 0; while (cond) { __builtin_amdgcn_s_sleep(1); \
    if ((++_sp & 255u) == 0u) { if (xb_ld(&(bar)[XB_TMO])) break; if (_sp > XB_SPIN_CAP) { atomicAdd(&(bar)[XB_TMO], 1u); break; } } } } while (0)

struct XcdBarrier {
    unsigned* bar; unsigned x;
    volatile LAS unsigned* st;
};

__device__ __forceinline__ XcdBarrier xcd_barrier_post(unsigned* bar, volatile LAS unsigned* st) {
    XcdBarrier b; b.bar = bar; b.x = xb_xcc_id(); b.st = st;
    if (threadIdx.x == 0) (void)xb_add(&bar[XB_XCNT(b.x)], 1u);
    return b;
}
__device__ __forceinline__ void xcd_barrier_complete(unsigned* bar, unsigned x, unsigned& nloc, unsigned& nx) {
    const unsigned G = gridDim.x * gridDim.y * gridDim.z;
    unsigned sum, cnt, mine, sp = 0u;
    for (;;) {
        sum = 0u; cnt = 0u; mine = 0u;
#pragma unroll
        for (unsigned j = 0; j < 16; ++j) { const unsigned c = xb_ld(&bar[XB_XCNT(j)]); sum += c; cnt += (c > 0u) ? 1u : 0u; mine = (j == x) ? c : mine; }
        if (sum == G) break;
        __builtin_amdgcn_s_sleep(1);
        if ((++sp & 255u) == 0u) { if (xb_ld(&bar[XB_TMO])) break; if (sp > XB_SPIN_CAP) { atomicAdd(&bar[XB_TMO], 1u); break; } }
    }
    nloc = mine > 0u ? mine : 1u; nx = cnt > 0u ? cnt : 1u;
}

__device__ __forceinline__ void xcd_barrier(const XcdBarrier& b) {
    asm volatile("s_waitcnt vmcnt(0)" ::: "memory");
    __syncthreads();
    if (threadIdx.x == 0) {
        unsigned* bar = b.bar;
        __builtin_amdgcn_s_waitcnt(0);
        unsigned nloc = b.st[0], nx = b.st[1];
        if (nloc == 0u) { xcd_barrier_complete(bar, b.x, nloc, nx); b.st[0] = nloc; b.st[1] = nx; }
        const unsigned old = xb_add(&bar[XB_XSUB(b.x)], 1u);
        const unsigned gen = old / nloc;
        if (old + 1u == (gen + 1u) * nloc) {
            __builtin_amdgcn_fence(__ATOMIC_RELEASE, "agent");
            asm volatile("s_waitcnt vmcnt(0)" ::: "memory");
            const unsigned og = xb_add(&bar[XB_TOP], 1u);
            const unsigned tg = og / nx;
            if (og + 1u == (tg + 1u) * nx) xb_add(&bar[XB_TOPGEN], 1u);
            else XB_SPIN(xb_ld(&bar[XB_TOPGEN]) == tg, bar);
            __builtin_amdgcn_fence(__ATOMIC_ACQUIRE, "agent");
            xb_add(&bar[XB_XGEN(b.x)], 1u);
            asm volatile("s_waitcnt vmcnt(0)" ::: "memory");
        } else {
            XB_SPIN(xb_ld(&bar[XB_XGEN(b.x)]) == gen, bar);
            __builtin_amdgcn_fence(__ATOMIC_ACQUIRE, "agent");
            asm volatile("s_waitcnt vmcnt(0)" ::: "memory");
        }
    }
    __syncthreads();
}

constexpr int NWAVES = 8;
constexpr int DM = 1024, BATCH = 16, SEQ = 2048, DEPTH = 2, HD = 64, NH = 8, NGRP = 8, AW = 512, GWD = 512, INW = 2560, MOBA = 256, NBLK = SEQ / MOBA, GCH = 128, DFF = 2816, PLE = 256;
constexpr int M = BATCH * SEQ;
constexpr float RMS_EPS = 1e-6f, LN_EPS = 1e-5f;
constexpr float LOG2E = 1.4426950408889634f;
constexpr float QSCALE = 0.125f * LOG2E;

constexpr size_t MiB = 1u << 20;
constexpr size_t WS_CTL = 0, CTL_ZERO_BYTES = 1 * MiB;
constexpr size_t WL_GU1 = 0, WL_D1 = WL_GU1 + (size_t)2 * DFF * DM * 2, WL_GU2 = WL_D1 + (size_t)DM * DFF * 2, WL_D2 = WL_GU2 + (size_t)2 * DFF * DM * 2,
                 WL_IN = WL_D2 + (size_t)DM * DFF * 2, WL_OUT = WL_IN + (size_t)INW * DM * 2, WL_PG = WL_OUT + (size_t)DM * DM * 2, WL_PP = WL_PG + (size_t)DM * DM * 2, WL_STRIDE = WL_PP + (size_t)DM * PLE * 2;
constexpr size_t WS_W = 2 * MiB;
static_assert(WS_W + 2 * WL_STRIDE <= 88 * MiB, "weights");
constexpr size_t WS_PBF = 88 * MiB;
constexpr size_t WS_XN = 120 * MiB;
constexpr size_t WS_HB = 184 * MiB;
constexpr size_t WS_MRG = 360 * MiB;
constexpr size_t WS_FB = 424 * MiB;
constexpr size_t WS_KM = 488 * MiB;
constexpr size_t WS_SSQ = 489 * MiB;
constexpr size_t WS_END = 490 * MiB;
constexpr size_t ZSTRIDE = (size_t)M * 512;
static_assert(WS_HB + (size_t)M * DFF * 2 <= WS_MRG && 5 * ZSTRIDE * 2 <= (size_t)M * DFF * 2, "overlay");
constexpr int CW_TMO = 0, CW_CODE = 1, CW_BAR = 4096;

constexpr int RING_OFF = 0, RING_BYTES = 131072;
constexpr int LDSCTL_OFF = RING_BYTES, MISC_OFF = LDSCTL_OFF + 320, EXTRA_OFF = RING_BYTES + 1024;
constexpr int LDS_BYTES = 147456;

struct Frame {
    LAS unsigned char* lds;
    volatile LAS unsigned* MISC;
    gu32* ctl;
    int tid, lane, wave, G;
    float* out; unsigned char* ws;
};
enum { I_X = 0, I_P, I_F1PRE, I_F1G, I_F1U, I_F1D, I_F1POST, I_MIXPRE, I_WIN, I_LNG, I_LNB, I_WS, I_BS, I_AON, I_GON, I_WOUT, I_MIXPOST, I_F2PRE, I_F2G, I_F2U, I_F2D, I_F2POST, I_PLEPRE, I_PLEG, I_PLEP, I_PLEPOST };

__device__ __forceinline__ float wave_sum(float v) {
#pragma unroll
    for (int o = 1; o < 64; o <<= 1) v += __shfl_xor(v, o);
    return v;
}
__device__ __forceinline__ float wave_max(float v) {
#pragma unroll
    for (int o = 1; o < 64; o <<= 1) v = fmaxf(v, __shfl_xor(v, o));
    return v;
}
__device__ __forceinline__ float bf2f(bf16 b) { return __uint_as_float((unsigned)b << 16); }
__device__ __forceinline__ int fresh_lane() { int l = (int)(threadIdx.x & 63u); asm volatile("" : "+v"(l)); return l; }

__device__ __forceinline__ void p0_transpose_item(const float* W, int K, int N, bf16* WT, LAS float* scr, int k0, int n0, int drow0, const float* gk, int lane) {
#pragma unroll 8
    for (int i = 0; i < 32; ++i) { const int kk = 2 * i + (lane >> 5); const float g = gk ? gk[kk] : 1.0f; scr[kk * 33 + (lane & 31)] = W[(size_t)(k0 + kk) * N + n0 + (lane & 31)] * g; }
    LDS_WAIT(); asm volatile("" ::: "memory");
    const int c = lane & 7;
#pragma unroll
    for (int j = 0; j < 4; ++j) { const int n = (lane >> 3) + 8 * j; const LAS float* s = scr + (8 * c) * 33 + n;
        v4u o; o.x = pk2(s[0 * 33], s[1 * 33]); o.y = pk2(s[2 * 33], s[3 * 33]); o.z = pk2(s[4 * 33], s[5 * 33]); o.w = pk2(s[6 * 33], s[7 * 33]);
        *(GAS v4u*)(WT + (size_t)(drow0 + n) * K + k0 + 8 * c) = o; }
    LDS_WAIT(); asm volatile("" ::: "memory");
}
__device__ __forceinline__ bool p0_matrix(int& r, const float* W, int K, int N, bf16* WT, int mode, const float* gain, const float* gain2, LAS float* scr, int lane) {
    const int nblk = N / 32, items = (K / 64) * nblk;
    if (r >= items) { r -= items; return false; }
    const int kb = r / nblk, nb = r % nblk, k0 = 64 * kb, n0 = 32 * nb;
    const int drow0 = (mode == 0) ? n0 : ((n0 >> 7) * 256 + (n0 & 127) + (mode == 2 ? 128 : 0));
    const float* gk = gain ? ((gain2 && k0 >= 512) ? gain2 + (k0 - 512) : gain + k0) : nullptr;
    p0_transpose_item(W, K, N, WT, scr, k0, n0, drow0, gk, lane);
    return true;
}
__device__ __forceinline__ void rms_row_to_bf16(const float* xrow, bf16* orow, int lane) {
    const GAS f32x4* xr = (const GAS f32x4*)xrow + lane;
    f32x4 v[4]; float s = 0.f;
#pragma unroll
    for (int j = 0; j < 4; ++j) { v[j] = xr[64 * j]; s += (v[j].x * v[j].x + v[j].y * v[j].y) + (v[j].z * v[j].z + v[j].w * v[j].w); }
    const float r = 1.0f / sqrtf(wave_sum(s) * (1.f / DM) + RMS_EPS);
    GAS unsigned long long* o8 = (GAS unsigned long long*)orow + lane;
#pragma unroll
    for (int j = 0; j < 4; ++j) o8[64 * j] = (unsigned long long)pk2(v[j].x * r, v[j].y * r) | ((unsigned long long)pk2(v[j].z * r, v[j].w * r) << 32);
}
struct Args { const float* in[26]; float* out; unsigned char* ws; };
__device__ __forceinline__ void p0_prologue(Frame& F, const Args& A) {
    LAS float* scr = (LAS float*)(F.lds + RING_OFF + F.wave * 16384);
    const int gw = blockIdx.x * NWAVES + F.wave, NGW = F.G * NWAVES;
    constexpr int ITEMS_L = 4 * (DM / 64) * (DFF / 32) + 2 * (DFF / 64) * (DM / 32) + (DM / 64) * (INW / 32) + 2 * (DM / 64) * (DM / 32) + (PLE / 64) * (DM / 32);
    for (int it = gw; it < DEPTH * ITEMS_L; it += NGW) {
        const int l = it / ITEMS_L; int r = it % ITEMS_L;
        bf16* wl = (bf16*)(F.ws + WS_W + (size_t)l * WL_STRIDE);
        if (p0_matrix(r, A.in[I_F1G] + (size_t)l * DM * DFF, DM, DFF, wl + WL_GU1 / 2, 1, A.in[I_F1PRE] + l * DM, nullptr, scr, F.lane)) continue;
        if (p0_matrix(r, A.in[I_F1U] + (size_t)l * DM * DFF, DM, DFF, wl + WL_GU1 / 2, 2, A.in[I_F1PRE] + l * DM, nullptr, scr, F.lane)) continue;
        if (p0_matrix(r, A.in[I_F1D] + (size_t)l * DFF * DM, DFF, DM, wl + WL_D1 / 2, 0, nullptr, nullptr, scr, F.lane)) continue;
        if (p0_matrix(r, A.in[I_F2G] + (size_t)l * DM * DFF, DM, DFF, wl + WL_GU2 / 2, 1, A.in[I_F2PRE] + l * DM, nullptr, scr, F.lane)) continue;
        if (p0_matrix(r, A.in[I_F2U] + (size_t)l * DM * DFF, DM, DFF, wl + WL_GU2 / 2, 2, A.in[I_F2PRE] + l * DM, nullptr, scr, F.lane)) continue;
        if (p0_matrix(r, A.in[I_F2D] + (size_t)l * DFF * DM, DFF, DM, wl + WL_D2 / 2, 0, nullptr, nullptr, scr, F.lane)) continue;
        if (p0_matrix(r, A.in[I_WIN] + (size_t)l * DM * INW, DM, INW, wl + WL_IN / 2, 0, A.in[I_MIXPRE] + l * DM, nullptr, scr, F.lane)) continue;
        if (p0_matrix(r, A.in[I_WOUT] + (size_t)l * DM * DM, DM, DM, wl + WL_OUT / 2, 0, A.in[I_AON] + l * AW, A.in[I_GON] + l * GWD, scr, F.lane)) continue;
        if (p0_matrix(r, A.in[I_PLEG] + (size_t)l * DM * DM, DM, DM, wl + WL_PG / 2, 0, A.in[I_PLEPRE] + l * DM, nullptr, scr, F.lane)) continue;
        p0_matrix(r, A.in[I_PLEP] + (size_t)l * PLE * DM, PLE, DM, wl + WL_PP / 2, 0, nullptr, nullptr, scr, F.lane);
    }
    { const GAS f32x4* p4 = (const GAS f32x4*)A.in[I_P]; GAS v4u* o = (GAS v4u*)(F.ws + WS_PBF); const int n8 = DEPTH * M * PLE / 8;
      for (int i = blockIdx.x * (NWAVES * 64) + F.tid; i < n8; i += F.G * NWAVES * 64) { const f32x4 a = p4[2 * i], b = p4[2 * i + 1]; v4u w; w.x = pk2(a.x, a.y); w.y = pk2(a.z, a.w); w.z = pk2(b.x, b.y); w.w = pk2(b.z, b.w); o[i] = w; } }
    for (int m = gw; m < M; m += NGW) rms_row_to_bf16(A.in[I_X] + (size_t)m * DM, (bf16*)(F.ws + WS_XN) + (size_t)m * DM, F.lane);
}

__device__ __forceinline__ void thin_phase(Frame& F, const bf16* Fb, const float* hin, float* hout, const float* gpost, float coef, bf16* xn) {
    const int gw = blockIdx.x * NWAVES + F.wave, NGW = F.G * NWAVES, lane = fresh_lane();
    f32x4 gp[4];
#pragma unroll
    for (int j = 0; j < 4; ++j) gp[j] = *((const GAS f32x4*)gpost + lane + 64 * j);
    for (int m = gw; m < M; m += NGW) {
        const GAS unsigned long long* fr = (const GAS unsigned long long*)(Fb + (size_t)m * DM) + lane;
        const GAS f32x4* hr = (const GAS f32x4*)(hin + (size_t)m * DM) + lane;
        f32x4 f[4], h[4]; float s = 0.f;
#pragma unroll
        for (int j = 0; j < 4; ++j) { const unsigned long long w = fr[64 * j]; h[j] = hr[64 * j];
            f[j].x = __uint_as_float((unsigned)w << 16); f[j].y = __uint_as_float((unsigned)w & 0xffff0000u); f[j].z = __uint_as_float((unsigned)(w >> 32) << 16); f[j].w = __uint_as_float((unsigned)(w >> 32) & 0xffff0000u);
            s += (f[j].x * f[j].x + f[j].y * f[j].y) + (f[j].z * f[j].z + f[j].w * f[j].w); }
        const float r = coef / sqrtf(wave_sum(s) * (1.f / DM) + RMS_EPS); float s2 = 0.f;
#pragma unroll
        for (int j = 0; j < 4; ++j) { h[j] = h[j] + f[j] * gp[j] * r; s2 += (h[j].x * h[j].x + h[j].y * h[j].y) + (h[j].z * h[j].z + h[j].w * h[j].w); }
        GAS f32x4* ho = (GAS f32x4*)(hout + (size_t)m * DM) + lane;
#pragma unroll
        for (int j = 0; j < 4; ++j) ho[64 * j] = h[j];
        if (xn) { const float r2 = 1.0f / sqrtf(wave_sum(s2) * (1.f / DM) + RMS_EPS);
            GAS unsigned long long* o8 = (GAS unsigned long long*)(xn + (size_t)m * DM) + lane;
#pragma unroll
            for (int j = 0; j < 4; ++j) o8[64 * j] = (unsigned long long)pk2(h[j].x * r2, h[j].y * r2) | ((unsigned long long)pk2(h[j].z * r2, h[j].w * r2) << 32); }
    }
}

__device__ __forceinline__ void gmlp_naive_phase(Frame& F, const float* ln_g, const float* ln_b, const float* w_s, const float* b_s) {
    const bf16* GU = (const bf16*)(F.ws + WS_HB) + 3 * ZSTRIDE; const bf16* GV = GU + ZSTRIDE; const bf16* KB = (const bf16*)(F.ws + WS_HB) + ZSTRIDE;
    bf16* MRG = (bf16*)(F.ws + WS_MRG);
    const int g = F.wave, lane = fresh_lane();
    LAS bf16* vn = (LAS bf16*)(F.lds + RING_OFF + g * 16384);
    LAS float* ssqt = (LAS float*)(F.lds + EXTRA_OFF);
    const float lg = ln_g[g * 64 + lane], lb = ln_b[g * 64 + lane];
    const float* w = w_s + (size_t)g * GCH * GCH; const float* bs = b_s + (size_t)g * GCH;
    for (int unit = blockIdx.x; unit < M / GCH; unit += F.G) {
        const size_t R0 = (size_t)unit * GCH;
        for (int s = 0; s < GCH; ++s) { const float v = bf2f(GV[(R0 + s) * 512 + g * 64 + lane]); const float mean = wave_sum(v) * (1.f / 64.f); const float d = v - mean;
            const float var = wave_sum(d * d) * (1.f / 64.f); const float y = d * (1.0f / sqrtf(var + LN_EPS)) * lg + lb; vn[s * 64 + lane] = (bf16)f2bf(y); }
        LDS_WAIT(); asm volatile("" ::: "memory");
        for (int t = 0; t < GCH; ++t) { float a = 0.f;
            for (int s = 0; s <= t; ++s) a += w[t * GCH + s] * bf2f(vn[s * 64 + lane]);
            a += bs[t];
            const float o = bf2f(GU[(R0 + t) * 512 + g * 64 + lane]) * a; const float ss = wave_sum(o * o);
            MRG[(R0 + t) * DM + AW + g * 64 + lane] = (bf16)f2bf(o); if (lane == 0) ssqt[t * 8 + g] = ss; }
        VM_WAIT(); LDS_WAIT(); __syncthreads();
        for (int t = 0; t < GCH; ++t) { float q = 0.f;
#pragma unroll
            for (int k = 0; k < 8; ++k) q += ssqt[t * 8 + k];
            const float r = 1.0f / sqrtf(q * (1.f / GWD) + RMS_EPS); bf16* p = MRG + (R0 + t) * DM + AW + g * 64 + lane; *p = (bf16)f2bf(bf2f(*p) * r); }
        LDS_WAIT(); __syncthreads();
    }
    float* KM = (float*)(F.ws + WS_KM);
    for (int item = blockIdx.x * NWAVES + F.wave; item < BATCH * NH * NBLK; item += F.G * NWAVES) {
        const int b = item >> 6, h = (item >> 3) & 7, n = item & 7; const bf16* kp = KB + ((size_t)b * SEQ + n * MOBA) * 512 + h * 64 + lane; float s = 0.f;
        for (int j = 0; j < MOBA; ++j) s += bf2f(kp[(size_t)j * 512]);
        KM[item * 64 + lane] = s * (1.f / MOBA);
    }
}

__device__ __forceinline__ void attn_naive_phase(Frame& F) {
    const bf16* Q = (const bf16*)(F.ws + WS_HB); const bf16* KB = Q + ZSTRIDE; const bf16* VB = KB + ZSTRIDE;
    bf16* MRG = (bf16*)(F.ws + WS_MRG); const float* KM = (const float*)(F.ws + WS_KM); float* SSQ = (float*)(F.ws + WS_SSQ);
    const int lane = fresh_lane(); LAS float* qsh = (LAS float*)(F.lds + RING_OFF + F.wave * 256);
    for (int idx = blockIdx.x * NWAVES + F.wave; idx < BATCH * NH * SEQ; idx += F.G * NWAVES) {
        const int bh = idx & 127, t = idx >> 7, b = bh >> 3, h = bh & 7, own = t >> 8; const size_t row = (size_t)b * SEQ + t;
        const float qd = bf2f(Q[row * 512 + h * 64 + lane]);
        const float sl2 = exp2f(-(float)(h + 1)) * LOG2E;
        float gv[NBLK - 1];
#pragma unroll
        for (int n = 0; n < NBLK - 1; ++n) { const float pr = (n < own) ? qd * KM[((size_t)bh * NBLK + n) * 64 + lane] : 0.f; const float sgate = wave_sum(pr); gv[n] = (n < own) ? sgate : -INFINITY; }
        unsigned mask = 0u;
#pragma unroll
        for (int k = 0; k < 3; ++k) { int best = -1; float bv = -INFINITY;
#pragma unroll
            for (int n = 0; n < NBLK - 1; ++n) if (!((mask >> n) & 1u) && gv[n] > bv) { bv = gv[n]; best = n; }
            if (best >= 0) mask |= 1u << best; }
        mask = (unsigned)__builtin_amdgcn_readfirstlane((int)mask);
        qsh[lane] = qd; LDS_WAIT(); asm volatile("" ::: "memory");
        float mrun = -INFINITY, lrun = 0.f, o = 0.f;
        for (int bi = 0; bi <= NBLK - 1; ++bi) {
            int nb; if (bi == 0) nb = own; else { nb = bi - 1; if (!((mask >> nb) & 1u)) continue; }
            for (int tile = 0; tile < 4; ++tile) {
                const int s0 = nb * MOBA + tile * 64; if (s0 > t) break;
                const int s = s0 + lane; const GAS v4u* kr = (const GAS v4u*)(KB + ((size_t)b * SEQ + s) * 512 + h * 64);
                float dot = 0.f;
#pragma unroll
                for (int c = 0; c < 8; ++c) { const v4u kk = kr[c]; float qs[64]; { const f32x4 qa = *(const LAS f32x4*)(qsh + 8 * c), qb = *(const LAS f32x4*)(qsh + 8 * c + 4); qs[8*c]=qa.x; qs[8*c+1]=qa.y; qs[8*c+2]=qa.z; qs[8*c+3]=qa.w; qs[8*c+4]=qb.x; qs[8*c+5]=qb.y; qs[8*c+6]=qb.z; qs[8*c+7]=qb.w; }
                    dot += qs[8 * c + 0] * __uint_as_float(kk.x << 16) + qs[8 * c + 1] * __uint_as_float(kk.x & 0xffff0000u) + qs[8 * c + 2] * __uint_as_float(kk.y << 16) + qs[8 * c + 3] * __uint_as_float(kk.y & 0xffff0000u)
                         + qs[8 * c + 4] * __uint_as_float(kk.z << 16) + qs[8 * c + 5] * __uint_as_float(kk.z & 0xffff0000u) + qs[8 * c + 6] * __uint_as_float(kk.w << 16) + qs[8 * c + 7] * __uint_as_float(kk.w & 0xffff0000u); }
                float x = dot - sl2 * (float)(t - s); if (s > t) x = -INFINITY;
                const float mnew = fmaxf(mrun, wave_max(x)); const float p = exp2f(x - mnew), f = exp2f(mrun - mnew);
                lrun = lrun * f + wave_sum(p); o *= f; mrun = mnew;
                const bf16* vp = VB + ((size_t)b * SEQ + s0) * 512 + h * 64 + lane;
#pragma unroll 8
                for (int j = 0; j < 64; ++j) { const float pj = __uint_as_float((unsigned)__builtin_amdgcn_readlane((int)__float_as_uint(p), j)); o += pj * bf2f(vp[(size_t)j * 512]); }
            }
        }
        const float res = o / lrun; const float ss = wave_sum(res * res);
        MRG[row * DM + h * 64 + lane] = (bf16)f2bf(res); if (lane == 0) SSQ[row * NH + h] = ss;
    }
}
__device__ __forceinline__ void attn_norm_phase(Frame& F) {
    bf16* MRG = (bf16*)(F.ws + WS_MRG); const float* SSQ = (const float*)(F.ws + WS_SSQ); const int lane = fresh_lane();
    for (int m = blockIdx.x * NWAVES + F.wave; m < M; m += F.G * NWAVES) {
        float q = 0.f;
#pragma unroll
        for (int k = 0; k < NH; ++k) q += SSQ[(size_t)m * NH + k];
        const float r = 1.0f / sqrtf(q * (1.f / AW) + RMS_EPS);
        GAS v4u* p = (GAS v4u*)(MRG + (size_t)m * DM) + lane; v4u w = *p;
        w.x = pk2(__uint_as_float(w.x << 16) * r, __uint_as_float(w.x & 0xffff0000u) * r); w.y = pk2(__uint_as_float(w.y << 16) * r, __uint_as_float(w.y & 0xffff0000u) * r);
        w.z = pk2(__uint_as_float(w.z << 16) * r, __uint_as_float(w.z & 0xffff0000u) * r); w.w = pk2(__uint_as_float(w.w << 16) * r, __uint_as_float(w.w & 0xffff0000u) * r);
        *p = w;
    }
}

#ifndef PG8_SP2
#define PG8_SP2 true
#endif
#ifndef PG8_ALIGN
#define PG8_ALIGN true
#endif
__global__ void __launch_bounds__(NWAVES * 64, 2) mk_fwd(Args args) {
    extern __shared__ __attribute__((aligned(16))) unsigned char lds[];
    Frame F;
    F.lds = (LAS unsigned char*)lds; F.MISC = (volatile LAS unsigned*)(F.lds + MISC_OFF);
    F.tid = threadIdx.x; F.lane = F.tid & 63; F.wave = __builtin_amdgcn_readfirstlane(F.tid >> 6); F.G = gridDim.x;
    F.ws = args.ws; F.out = args.out; F.ctl = (gu32*)(args.ws + WS_CTL);
    for (int u = F.tid; u < (LDS_BYTES - LDSCTL_OFF) / 4; u += NWAVES * 64) ((LAS unsigned*)(F.lds + LDSCTL_OFF))[u] = 0u;
    __syncthreads();
    XcdBarrier bar = xcd_barrier_post((unsigned*)(F.ctl + CW_BAR), F.MISC + 8);
#define GRID_BAR() xcd_barrier(bar)
    using pg8::bf16_t;
    bf16_t* XN = (bf16_t*)(F.ws + WS_XN); bf16_t* HB = (bf16_t*)(F.ws + WS_HB); bf16_t* MRG = (bf16_t*)(F.ws + WS_MRG); bf16_t* FB = (bf16_t*)(F.ws + WS_FB);

    p0_prologue(F, args); GRID_BAR();

        { constexpr int l = 0;

    {
        const bf16_t* wl = (const bf16_t*)(F.ws + WS_W + (size_t)l * WL_STRIDE);
        { pg8::Gemm g{XN, wl + WL_GU1 / 2, M, 2 * DFF, DM}; pg8::StaticOrder S; S.init(M, 2 * DFF, F.G, (int)blockIdx.x); pg8::EpiSwiGLU E{HB, DFF};
          pg8::gemm_phase<pg8::EpiSwiGLU, pg8::StaticOrder, PG8_ALIGN, PG8_SP2>(F.lds + RING_OFF, g, S, E); }
        GRID_BAR();
        { pg8::Gemm g{HB, wl + WL_D1 / 2, M, DM, DFF}; pg8::StaticOrder S; S.init(M, DM, F.G, (int)blockIdx.x); pg8::EpiBf16<0> E{FB, DM, nullptr, 0, 0, 1.f};
          pg8::gemm_phase<pg8::EpiBf16<0>, pg8::StaticOrder, PG8_ALIGN, PG8_SP2>(F.lds + RING_OFF, g, S, E); }
        GRID_BAR();
        thin_phase(F, (const bf16*)FB, l == 0 ? args.in[I_X] : F.out, F.out, args.in[I_F1POST] + l * DM, 0.5f, (bf16*)XN);
        GRID_BAR();
        { pg8::Gemm g{XN, wl + WL_IN / 2, M, INW, DM}; pg8::StaticOrder S; S.init(M, INW, F.G, (int)blockIdx.x); pg8::EpiInProj E{HB, ZSTRIDE, QSCALE};
          pg8::gemm_phase<pg8::EpiInProj, pg8::StaticOrder, PG8_ALIGN, PG8_SP2>(F.lds + RING_OFF, g, S, E); }
        GRID_BAR();
        gmlp_naive_phase(F, args.in[I_LNG] + l * GWD, args.in[I_LNB] + l * GWD, args.in[I_WS] + (size_t)l * NGRP * GCH * GCH, args.in[I_BS] + (size_t)l * NGRP * GCH);
        GRID_BAR();
        { const attn_body::AttnTensors AT{(const attn_body::bf16*)(F.ws + WS_HB), (const attn_body::bf16*)(F.ws + WS_HB) + ZSTRIDE, (const attn_body::bf16*)(F.ws + WS_HB) + 2 * ZSTRIDE, (attn_body::bf16*)(F.ws + WS_MRG), (float*)(F.ws + WS_SSQ), (const float*)(F.ws + WS_KM)};
          const attn_body::MobaOrder S((int)F.G, (int)blockIdx.x); attn_body::attn_phase<attn_body::MobaOrder>((char*)lds + RING_OFF, AT, S); }
        GRID_BAR();
        attn_norm_phase(F);
        GRID_BAR();
        { pg8::Gemm g{MRG, wl + WL_OUT / 2, M, DM, DM}; pg8::StaticOrder S; S.init(M, DM, F.G, (int)blockIdx.x); pg8::EpiBf16<0> E{FB, DM, nullptr, 0, 0, 1.f};
          pg8::gemm_phase<pg8::EpiBf16<0>, pg8::StaticOrder, PG8_ALIGN, PG8_SP2>(F.lds + RING_OFF, g, S, E); }
        GRID_BAR();
        thin_phase(F, (const bf16*)FB, F.out, F.out, args.in[I_MIXPOST] + l * DM, 1.0f, (bf16*)XN);
        GRID_BAR();
        { pg8::Gemm g{XN, wl + WL_GU2 / 2, M, 2 * DFF, DM}; pg8::StaticOrder S; S.init(M, 2 * DFF, F.G, (int)blockIdx.x); pg8::EpiSwiGLU E{HB, DFF};
          pg8::gemm_phase<pg8::EpiSwiGLU, pg8::StaticOrder, PG8_ALIGN, PG8_SP2>(F.lds + RING_OFF, g, S, E); }
        GRID_BAR();
        { pg8::Gemm g{HB, wl + WL_D2 / 2, M, DM, DFF}; pg8::StaticOrder S; S.init(M, DM, F.G, (int)blockIdx.x); pg8::EpiBf16<0> E{FB, DM, nullptr, 0, 0, 1.f};
          pg8::gemm_phase<pg8::EpiBf16<0>, pg8::StaticOrder, PG8_ALIGN, PG8_SP2>(F.lds + RING_OFF, g, S, E); }
        GRID_BAR();
        { pg8::Gemm g{(const bf16_t*)(F.ws + WS_PBF) + (size_t)l * M * PLE, wl + WL_PP / 2, M, DM, PLE}; pg8::StaticOrder S; S.init(M, DM, F.G, (int)blockIdx.x); pg8::EpiBf16<0> E{HB, DM, nullptr, 0, 0, 1.f};
          pg8::gemm_phase<pg8::EpiBf16<0>, pg8::StaticOrder, PG8_ALIGN, PG8_SP2>(F.lds + RING_OFF, g, S, E); }
        thin_phase(F, (const bf16*)FB, F.out, F.out, args.in[I_F2POST] + l * DM, 0.5f, (bf16*)XN);
        GRID_BAR();
        { pg8::Gemm g{XN, wl + WL_PG / 2, M, DM, DM}; pg8::StaticOrder S; S.init(M, DM, F.G, (int)blockIdx.x); pg8::EpiPleGate E{FB, HB, DM};
          pg8::gemm_phase<pg8::EpiPleGate, pg8::StaticOrder, PG8_ALIGN, PG8_SP2>(F.lds + RING_OFF, g, S, E); }
        GRID_BAR();
        thin_phase(F, (const bf16*)FB, F.out, F.out, args.in[I_PLEPOST] + l * DM, 1.0f, l + 1 < DEPTH ? (bf16*)XN : (bf16*)nullptr);
        if (l + 1 < DEPTH) GRID_BAR();
    }
        }
    { constexpr int l = 1;

    {
        const bf16_t* wl = (const bf16_t*)(F.ws + WS_W + (size_t)l * WL_STRIDE);
        { pg8::Gemm g{XN, wl + WL_GU1 / 2, M, 2 * DFF, DM}; pg8::StaticOrder S; S.init(M, 2 * DFF, F.G, (int)blockIdx.x); pg8::EpiSwiGLU E{HB, DFF};
          pg8::gemm_phase<pg8::EpiSwiGLU, pg8::StaticOrder, PG8_ALIGN, PG8_SP2>(F.lds + RING_OFF, g, S, E); }
        GRID_BAR();
        { pg8::Gemm g{HB, wl + WL_D1 / 2, M, DM, DFF}; pg8::StaticOrder S; S.init(M, DM, F.G, (int)blockIdx.x); pg8::EpiBf16<0> E{FB, DM, nullptr, 0, 0, 1.f};
          pg8::gemm_phase<pg8::EpiBf16<0>, pg8::StaticOrder, PG8_ALIGN, PG8_SP2>(F.lds + RING_OFF, g, S, E); }
        GRID_BAR();
        thin_phase(F, (const bf16*)FB, l == 0 ? args.in[I_X] : F.out, F.out, args.in[I_F1POST] + l * DM, 0.5f, (bf16*)XN);
        GRID_BAR();
        { pg8::Gemm g{XN, wl + WL_IN / 2, M, INW, DM}; pg8::StaticOrder S; S.init(M, INW, F.G, (int)blockIdx.x); pg8::EpiInProj E{HB, ZSTRIDE, QSCALE};
          pg8::gemm_phase<pg8::EpiInProj, pg8::StaticOrder, PG8_ALIGN, PG8_SP2>(F.lds + RING_OFF, g, S, E); }
        GRID_BAR();
        gmlp_naive_phase(F, args.in[I_LNG] + l * GWD, args.in[I_LNB] + l * GWD, args.in[I_WS] + (size_t)l * NGRP * GCH * GCH, args.in[I_BS] + (size_t)l * NGRP * GCH);
        GRID_BAR();
        { const attn_body::AttnTensors AT{(const attn_body::bf16*)(F.ws + WS_HB), (const attn_body::bf16*)(F.ws + WS_HB) + ZSTRIDE, (const attn_body::bf16*)(F.ws + WS_HB) + 2 * ZSTRIDE, (attn_body::bf16*)(F.ws + WS_MRG), (float*)(F.ws + WS_SSQ), (const float*)(F.ws + WS_KM)};
          const attn_body::MobaOrder S((int)F.G, (int)blockIdx.x); attn_body::attn_phase<attn_body::MobaOrder>((char*)lds + RING_OFF, AT, S); }
        GRID_BAR();
        attn_norm_phase(F);
        GRID_BAR();
        { pg8::Gemm g{MRG, wl + WL_OUT / 2, M, DM, DM}; pg8::StaticOrder S; S.init(M, DM, F.G, (int)blockIdx.x); pg8::EpiBf16<0> E{FB, DM, nullptr, 0, 0, 1.f};
          pg8::gemm_phase<pg8::EpiBf16<0>, pg8::StaticOrder, PG8_ALIGN, PG8_SP2>(F.lds + RING_OFF, g, S, E); }
        GRID_BAR();
        thin_phase(F, (const bf16*)FB, F.out, F.out, args.in[I_MIXPOST] + l * DM, 1.0f, (bf16*)XN);
        GRID_BAR();
        { pg8::Gemm g{XN, wl + WL_GU2 / 2, M, 2 * DFF, DM}; pg8::StaticOrder S; S.init(M, 2 * DFF, F.G, (int)blockIdx.x); pg8::EpiSwiGLU E{HB, DFF};
          pg8::gemm_phase<pg8::EpiSwiGLU, pg8::StaticOrder, PG8_ALIGN, PG8_SP2>(F.lds + RING_OFF, g, S, E); }
        GRID_BAR();
        { pg8::Gemm g{HB, wl + WL_D2 / 2, M, DM, DFF}; pg8::StaticOrder S; S.init(M, DM, F.G, (int)blockIdx.x); pg8::EpiBf16<0> E{FB, DM, nullptr, 0, 0, 1.f};
          pg8::gemm_phase<pg8::EpiBf16<0>, pg8::StaticOrder, PG8_ALIGN, PG8_SP2>(F.lds + RING_OFF, g, S, E); }
        GRID_BAR();
        { pg8::Gemm g{(const bf16_t*)(F.ws + WS_PBF) + (size_t)l * M * PLE, wl + WL_PP / 2, M, DM, PLE}; pg8::StaticOrder S; S.init(M, DM, F.G, (int)blockIdx.x); pg8::EpiBf16<0> E{HB, DM, nullptr, 0, 0, 1.f};
          pg8::gemm_phase<pg8::EpiBf16<0>, pg8::StaticOrder, PG8_ALIGN, PG8_SP2>(F.lds + RING_OFF, g, S, E); }
        thin_phase(F, (const bf16*)FB, F.out, F.out, args.in[I_F2POST] + l * DM, 0.5f, (bf16*)XN);
        GRID_BAR();
        { pg8::Gemm g{XN, wl + WL_PG / 2, M, DM, DM}; pg8::StaticOrder S; S.init(M, DM, F.G, (int)blockIdx.x); pg8::EpiPleGate E{FB, HB, DM};
          pg8::gemm_phase<pg8::EpiPleGate, pg8::StaticOrder, PG8_ALIGN, PG8_SP2>(F.lds + RING_OFF, g, S, E); }
        GRID_BAR();
        thin_phase(F, (const bf16*)FB, F.out, F.out, args.in[I_PLEPOST] + l * DM, 1.0f, l + 1 < DEPTH ? (bf16*)XN : (bf16*)nullptr);
        if (l + 1 < DEPTH) GRID_BAR();
    }
        }

}

extern "C" void kernel_launch(void* const* d_in, const int* in_sizes, int n_in, void* d_out, int out_size, void* d_ws, size_t ws_size, hipStream_t stream) {
    static int grid = 0;
    if (grid == 0) {
        if (n_in != 26 || in_sizes[0] != M * DM || out_size != M * DM || ws_size < WS_END) { fprintf(stderr, "kernel_launch: unexpected shapes (n_in %d, in0 %d, out %d, ws %zu)\n", n_in, n_in > 0 ? in_sizes[0] : -1, out_size, ws_size); grid = -1; return; }
        int dev = 0, cus = 0, per_cu = 0;
        if (hipGetDevice(&dev) != hipSuccess || hipDeviceGetAttribute(&cus, hipDeviceAttributeMultiprocessorCount, dev) != hipSuccess) { grid = -1; return; }
        if (hipFuncSetAttribute((const void*)mk_fwd, hipFuncAttributeMaxDynamicSharedMemorySize, LDS_BYTES) != hipSuccess) { fprintf(stderr, "kernel_launch: hipFuncSetAttribute failed\n"); grid = -1; return; }
        if (hipOccupancyMaxActiveBlocksPerMultiprocessor(&per_cu, (const void*)mk_fwd, NWAVES * 64, LDS_BYTES) != hipSuccess || per_cu < 1) { fprintf(stderr, "kernel_launch: occupancy query reports %d\n", per_cu); }
        (void)hipGetLastError();
        grid = cus;
    }
    if (grid < 0) return;
    if (hipMemsetAsync((char*)d_ws + WS_CTL, 0, CTL_ZERO_BYTES, stream) != hipSuccess) return;
    Args a{};
    for (int i = 0; i < 26; ++i) a.in[i] = (const float*)d_in[i];
    a.out = (float*)d_out; a.ws = (unsigned char*)d_ws;
    hipLaunchKernelGGL(mk_fwd, dim3(grid), dim3(NWAVES * 64), LDS_BYTES, stream, a);
}
```

```cpp
#include <hip/hip_runtime.h>
#include <cstdio>
#include <cstdint>
#include <cmath>
namespace pg8 {
#define PG8_LAS __attribute__((address_space(3)))
typedef unsigned short bf16_t;
typedef short bf16x8 __attribute__((ext_vector_type(8)));
typedef float f32x4 __attribute__((ext_vector_type(4)));
typedef unsigned u32x4 __attribute__((ext_vector_type(4)));
constexpr int BM = 256, BK = 64, HALF = 128, HTB = HALF * BK * 2  , STAGE_BYTES = 8 * HTB, NXCD = 8, WGM = 8;

__host__ __device__ __forceinline__ int lds_byte(int r, int c) { const int st = (r >> 4) * 2 + (c >> 5), rr = r & 15, cc = c & 31, ob = rr * 64 + cc * 2; return st * 1024 + (ob ^ (((ob >> 9) & 1) << 5)); }
__host__ __device__ __forceinline__ void stage_rc(int b, int& R, int& C) { const int st = b / 1024, sb = b % 1024, swz = sb ^ (((sb >> 9) & 1) << 5); R = (st >> 1) * 16 + swz / 64; C = (st & 1) * 32 + (swz % 64) / 2; }
__host__ __device__ __forceinline__ int perm32(int rho) { const int n = rho >> 4, i = rho & 15; return 8 * (i >> 2) + 4 * n + (i & 3); }

struct Unit { int pm, pn; };
struct Gemm { const bf16_t* A; const bf16_t* Bt; int M, N, K; };

struct StaticOrder {
    int nM, nN, nwg, G, c;
    __host__ __device__ void init(int M, int N, int G_, int c_) { nM = M / BM; nN = N / BM; nwg = nM * nN; G = G_; c = c_; }
    __host__ __device__ bool next(int i, Unit& u) const {
        const long L = (long)i * G + c; if (L >= nwg) return false;
        int wgid = (int)L; { const int q = nwg / NXCD, r = nwg % NXCD, xcd = wgid % NXCD, off = wgid / NXCD; wgid = (xcd < r ? xcd * (q + 1) : r * (q + 1) + (xcd - r) * q) + off; }
        const int nig = WGM * nN, gid = wgid / nig, fm = gid * WGM, gsz = (nM - fm) < WGM ? (nM - fm) : WGM;
        u.pm = fm + ((wgid % nig) % gsz); u.pn = (wgid % nig) / gsz; return true;
    }
    __device__ __forceinline__ void a_ready(const Unit&) const {}
    __device__ __forceinline__ void done(const Unit&) const {}
};

__device__ __forceinline__ unsigned cvt_pk_bf16(float lo, float hi) { unsigned r; asm volatile("v_cvt_pk_bf16_f32 %0, %1, %2" : "=v"(r) : "v"(lo), "v"(hi)); return r; }
typedef float f32x2 __attribute__((ext_vector_type(2)));
__device__ __forceinline__ f32x2 gelu_pk(f32x2 v) {
    const f32x2 av = __builtin_elementwise_abs(v), d = av * 0.2316418882f + 1.0f;
    f32x2 t; t.x = __builtin_amdgcn_rcpf(d.x); t.y = __builtin_amdgcn_rcpf(d.y);
    f32x2 q = t * 0.5307027145f + (-0.7265760135f); q = q * t + 0.7107068705f; q = q * t + (-0.142248368f); q = q * t + 0.127414796f; q = q * t;
    const f32x2 s = (v * v) * (-0.72134752044f);
    f32x2 e; e.x = __builtin_amdgcn_exp2f(s.x); e.y = __builtin_amdgcn_exp2f(s.y);
    const f32x2 m = v * (q * e), r = v - m;
    f32x2 o; o.x = v.x < 0.f ? m.x : r.x; o.y = v.y < 0.f ? m.y : r.y; return o;
}

template <int ACT  > struct EpiBf16 {
    static constexpr bool PERM = true, AFTER_DRAIN = false; static_assert(ACT == 0 || ACT == 1, "EpiBf16: ACT is 0 (none) or 1 (gelu_pk)");
    bf16_t* O; int ldc; const float* bias; int split_cols; size_t split_stride; float scale0;
    __device__ __forceinline__ void operator()(const f32x4 (&acc)[2][2][4][2], const Unit& u, int wr, int wc, int fr, int fq) const {
        const int row0 = u.pm * BM + wr * 64 + fr; int colt = u.pn * BM; bf16_t* base = O;
        float sc = 1.f; if (split_cols) { const int t = colt / split_cols; base += (size_t)t * split_stride; colt -= t * split_cols; if (t == 0) sc = scale0; }
        const int col0 = colt + wc * 32 + 8 * fq, bcol0 = u.pn * BM + wc * 32 + 8 * fq;
        f32x4 bv[2][2];
#pragma unroll
        for (int bj = 0; bj < 2; ++bj)
#pragma unroll
            for (int n = 0; n < 2; ++n) bv[bj][n] = bias ? *(const f32x4*)(bias + bcol0 + bj * HALF + 4 * n) : (f32x4){0.f, 0.f, 0.f, 0.f};
#pragma unroll
        for (int ai = 0; ai < 2; ++ai)
#pragma unroll
            for (int m = 0; m < 4; ++m) { bf16_t* rowp = base + (size_t)(row0 + ai * HALF + m * 16) * ldc + col0;
#pragma unroll
                for (int bj = 0; bj < 2; ++bj) { f32x4 v0 = acc[ai][bj][m][0] + bv[bj][0], v1 = acc[ai][bj][m][1] + bv[bj][1];
                    if (ACT == 1) { f32x2 a = gelu_pk((f32x2){v0[0], v0[1]}), b = gelu_pk((f32x2){v0[2], v0[3]}), c = gelu_pk((f32x2){v1[0], v1[1]}), d = gelu_pk((f32x2){v1[2], v1[3]});
                        v0 = (f32x4){a.x, a.y, b.x, b.y}; v1 = (f32x4){c.x, c.y, d.x, d.y}; }
                    v0 = v0 * sc; v1 = v1 * sc; u32x4 w; w.x = cvt_pk_bf16(v0[0], v0[1]); w.y = cvt_pk_bf16(v0[2], v0[3]); w.z = cvt_pk_bf16(v1[0], v1[1]); w.w = cvt_pk_bf16(v1[2], v1[3]);
                    *(u32x4*)(rowp + bj * HALF) = w; } }
    }
};
__device__ __forceinline__ float fast_sigmoid(float x) { return __builtin_amdgcn_rcpf(1.0f + __builtin_amdgcn_exp2f(x * -1.4426950408889634f)); }
struct EpiSwiGLU {
    static constexpr bool PERM = true, AFTER_DRAIN = false;
    bf16_t* O; int ldc;
    __device__ __forceinline__ void operator()(const f32x4 (&acc)[2][2][4][2], const Unit& u, int wr, int wc, int fr, int fq) const {
        const int row0 = u.pm * BM + wr * 64 + fr, col0 = u.pn * HALF + wc * 32 + 8 * fq;
#pragma unroll
        for (int ai = 0; ai < 2; ++ai)
#pragma unroll
            for (int m = 0; m < 4; ++m) { bf16_t* rowp = O + (size_t)(row0 + ai * HALF + m * 16) * ldc + col0;
                float o[8];
#pragma unroll
                for (int n = 0; n < 2; ++n)
#pragma unroll
                    for (int i = 0; i < 4; ++i) { const float g = acc[ai][0][m][n][i], up = acc[ai][1][m][n][i]; o[n * 4 + i] = g * fast_sigmoid(g) * up; }
                u32x4 w; w.x = cvt_pk_bf16(o[0], o[1]); w.y = cvt_pk_bf16(o[2], o[3]); w.z = cvt_pk_bf16(o[4], o[5]); w.w = cvt_pk_bf16(o[6], o[7]);
                *(u32x4*)rowp = w; }
    }
};
struct EpiInProj {
    static constexpr bool PERM = true, AFTER_DRAIN = false;
    bf16_t* Z; size_t zstride; float qscale;
    __device__ __forceinline__ void operator()(const f32x4 (&acc)[2][2][4][2], const Unit& u, int wr, int wc, int fr, int fq) const {
        const int t = u.pn >> 1; const int row0 = u.pm * BM + wr * 64 + fr, col0 = (u.pn & 1) * BM + wc * 32 + 8 * fq;
        bf16_t* base = Z + (size_t)t * zstride; const float sc = (t == 0) ? qscale : 1.0f; const bool act = (t >= 3);
#pragma unroll
        for (int ai = 0; ai < 2; ++ai)
#pragma unroll
            for (int m = 0; m < 4; ++m) { bf16_t* rowp = base + (size_t)(row0 + ai * HALF + m * 16) * 512 + col0;
#pragma unroll
                for (int bj = 0; bj < 2; ++bj) { f32x4 v0 = acc[ai][bj][m][0], v1 = acc[ai][bj][m][1];
                    if (act) { f32x2 a = gelu_pk((f32x2){v0[0], v0[1]}), b = gelu_pk((f32x2){v0[2], v0[3]}), c = gelu_pk((f32x2){v1[0], v1[1]}), d = gelu_pk((f32x2){v1[2], v1[3]});
                        v0 = (f32x4){a.x, a.y, b.x, b.y}; v1 = (f32x4){c.x, c.y, d.x, d.y}; }
                    v0 = v0 * sc; v1 = v1 * sc; u32x4 w; w.x = cvt_pk_bf16(v0[0], v0[1]); w.y = cvt_pk_bf16(v0[2], v0[3]); w.z = cvt_pk_bf16(v1[0], v1[1]); w.w = cvt_pk_bf16(v1[2], v1[3]);
                    *(u32x4*)(rowp + bj * HALF) = w; } }
    }
};
struct EpiPleGate {
    static constexpr bool PERM = true, AFTER_DRAIN = false;
    bf16_t* O; const bf16_t* E0; int ldc;
    __device__ __forceinline__ void operator()(const f32x4 (&acc)[2][2][4][2], const Unit& u, int wr, int wc, int fr, int fq) const {
        const int row0 = u.pm * BM + wr * 64 + fr, col0 = u.pn * BM + wc * 32 + 8 * fq;
#pragma unroll
        for (int ai = 0; ai < 2; ++ai)
#pragma unroll
            for (int m = 0; m < 4; ++m) { const size_t off = (size_t)(row0 + ai * HALF + m * 16) * ldc + col0;
#pragma unroll
                for (int bj = 0; bj < 2; ++bj) { const u32x4 e = *(const u32x4*)(E0 + off + bj * HALF); const f32x4 v0 = acc[ai][bj][m][0], v1 = acc[ai][bj][m][1];
                    float o[8];
                    o[0] = fast_sigmoid(v0[0]) * __uint_as_float(e.x << 16); o[1] = fast_sigmoid(v0[1]) * __uint_as_float(e.x & 0xffff0000u);
                    o[2] = fast_sigmoid(v0[2]) * __uint_as_float(e.y << 16); o[3] = fast_sigmoid(v0[3]) * __uint_as_float(e.y & 0xffff0000u);
                    o[4] = fast_sigmoid(v1[0]) * __uint_as_float(e.z << 16); o[5] = fast_sigmoid(v1[1]) * __uint_as_float(e.z & 0xffff0000u);
                    o[6] = fast_sigmoid(v1[2]) * __uint_as_float(e.w << 16); o[7] = fast_sigmoid(v1[3]) * __uint_as_float(e.w & 0xffff0000u);
                    u32x4 w; w.x = cvt_pk_bf16(o[0], o[1]); w.y = cvt_pk_bf16(o[2], o[3]); w.z = cvt_pk_bf16(o[4], o[5]); w.w = cvt_pk_bf16(o[6], o[7]);
                    *(u32x4*)(O + off + bj * HALF) = w; } }
    }
};
template <class Epi, class Sched, bool ALIGN_EPI = false, bool SP2 = false>
__device__ __forceinline__ void gemm_phase(PG8_LAS unsigned char* lds, const Gemm g, const Sched& S, const Epi& E, const int wv  ) {
    int tid_ = wv * 64 + (int)__builtin_amdgcn_mbcnt_hi(~0u, __builtin_amdgcn_mbcnt_lo(~0u, 0u)); asm volatile("" : "+v"(tid_));
    const int tid = tid_, wid = __builtin_amdgcn_readfirstlane(tid >> 6), lane = tid & 63, wr = wid >> 2, wc = wid & 3, fr = lane & 15, fq = lane >> 4;
    const int K = g.K, nt = K / BK;
    unsigned voffA[2], voffB[2];
#pragma unroll
    for (int i = 0; i < 2; ++i) { int R, C; stage_rc(tid * 16 + i * 8192, R, C); const int Rb = Epi::PERM ? ((R & ~31) + perm32(R & 31)) : R;
        voffA[i] = (unsigned)(R * K + C) * 2u; voffB[i] = (unsigned)(Rb * K + C) * 2u; }
    const size_t kstep = (size_t)(BK * 2);
    const size_t hstep = (size_t)HALF * K * 2;
    const size_t tstep = 2 * hstep;
    const unsigned ldsw = (unsigned)wid * 1024u;
    const int aoff = lds_byte(wr * 64 + fr, fq * 8), boff = lds_byte(wc * 32 + fr, fq * 8);
#define PG8_SA(b, h) (((b) * 2 + (h)) * HTB)
#define PG8_SB(b, h) ((4 + (b) * 2 + (h)) * HTB)
#define PG8_STAGE(bufoff, gbase, voff) do { _Pragma("unroll") for (int _i = 0; _i < 2; ++_i) \
        __builtin_amdgcn_global_load_lds((const unsigned*)((const char*)(gbase) + (voff)[_i]), (PG8_LAS unsigned*)(lds + (bufoff) + ldsw + _i * 8192), 16, 0, 0); } while (0)
#define PG8_LDA(dst, b, h) do { _Pragma("unroll") for (int m = 0; m < 4; ++m) _Pragma("unroll") for (int k = 0; k < 2; ++k) dst[m][k] = *(const PG8_LAS bf16x8*)(lds + PG8_SA(b, h) + aoff + m * 2048 + k * 1024); } while (0)
#define PG8_LDB(dst, b, h) do { _Pragma("unroll") for (int n = 0; n < 2; ++n) _Pragma("unroll") for (int k = 0; k < 2; ++k) dst[n][k] = *(const PG8_LAS bf16x8*)(lds + PG8_SB(b, h) + boff + n * 2048 + k * 1024); } while (0)
#define PG8_MMA(ai, bj, At, Bt) do { __builtin_amdgcn_s_setprio(1); _Pragma("unroll") for (int m = 0; m < 4; ++m) _Pragma("unroll") for (int n = 0; n < 2; ++n) _Pragma("unroll") for (int k = 0; k < 2; ++k) \
        acc[ai][bj][m][n] = __builtin_amdgcn_mfma_f32_16x16x32_bf16(Bt[n][k], At[m][k], acc[ai][bj][m][n], 0, 0, 0); __builtin_amdgcn_s_setprio(0); } while (0)
#define PG8_WAIT_V(n) asm volatile("s_waitcnt vmcnt(" #n ")" ::: "memory")
#define PG8_WAIT_L(n) asm volatile("s_waitcnt lgkmcnt(" #n ")" ::: "memory")
#define PG8_BAR __builtin_amdgcn_s_barrier()
#define PG8_SCHED __builtin_amdgcn_sched_barrier(0)
    Unit cur, nxt; int ui = 0;
    if (!S.next(0, cur)) return;
    f32x4 acc[2][2][4][2];
#pragma unroll
    for (int a = 0; a < 2; ++a)
#pragma unroll
        for (int b = 0; b < 2; ++b)
#pragma unroll
            for (int m = 0; m < 4; ++m)
#pragma unroll
                for (int n = 0; n < 2; ++n) acc[a][b][m][n] = (f32x4){0.f, 0.f, 0.f, 0.f};
    bf16x8 At[4][2], B0[2][2], B1[2][2];
    const char* cA = (const char*)g.A + (size_t)cur.pm * tstep; const char* cB = (const char*)g.Bt + (size_t)cur.pn * tstep;
    S.a_ready(cur);
    if constexpr (SP2) {
        PG8_STAGE(PG8_SB(0, 0), cB, voffB); PG8_STAGE(PG8_SB(0, 1), cB + hstep, voffB); PG8_STAGE(PG8_SA(0, 0), cA, voffA); PG8_STAGE(PG8_SA(0, 1), cA + hstep, voffA);
        if (wr == 1) PG8_BAR;
        PG8_WAIT_V(2); PG8_BAR;
        PG8_STAGE(PG8_SB(1, 0), cB + kstep, voffB); PG8_STAGE(PG8_SA(1, 0), cA + kstep, voffA); PG8_STAGE(PG8_SB(1, 1), cB + hstep + kstep, voffB);
        PG8_WAIT_V(6); PG8_BAR;
    } else {
        PG8_STAGE(PG8_SB(0, 0), cB, voffB); PG8_STAGE(PG8_SA(0, 0), cA, voffA); PG8_STAGE(PG8_SB(0, 1), cB + hstep, voffB); PG8_STAGE(PG8_SA(0, 1), cA + hstep, voffA);
        if (wr == 1) PG8_BAR;
        PG8_WAIT_V(4); PG8_BAR;
        PG8_STAGE(PG8_SB(1, 0), cB + kstep, voffB); PG8_STAGE(PG8_SA(1, 0), cA + kstep, voffA); PG8_STAGE(PG8_SB(1, 1), cB + hstep + kstep, voffB);
        PG8_WAIT_V(6); PG8_BAR;
    }
    for (;;) {
        const bool has_next = S.next(ui + 1, nxt);
        const char* nA = has_next ? (const char*)g.A + (size_t)nxt.pm * tstep : cA; const char* nB = has_next ? (const char*)g.Bt + (size_t)nxt.pn * tstep : cB;
        for (int t = 0; t < nt; t += 2) {
            const bool last = (t == nt - 2);
            const char* a1 = cA + (size_t)(t + 1) * kstep;
            const char* a2 = last ? nA : cA + (size_t)(t + 2) * kstep; const char* b2 = last ? nB : cB + (size_t)(t + 2) * kstep;
            const char* a3 = a2 + kstep; const char* b3 = b2 + kstep;
            if (last && has_next) S.a_ready(nxt);
            if constexpr (SP2) {
            PG8_LDB(B0, 0, 0); PG8_LDB(B1, 0, 1); PG8_SCHED; PG8_LDA(At, 0, 0); PG8_STAGE(PG8_SA(1, 1), a1 + hstep, voffA);
            PG8_WAIT_V(8); PG8_WAIT_L(0); PG8_BAR; PG8_MMA(0, 0, At, B0); PG8_MMA(0, 1, At, B1); PG8_BAR; PG8_SCHED;
            PG8_LDA(At, 0, 1); PG8_STAGE(PG8_SB(0, 0), b2, voffB); PG8_STAGE(PG8_SB(0, 1), b2 + hstep, voffB); PG8_STAGE(PG8_SA(0, 0), a2, voffA);
            PG8_WAIT_V(8); PG8_WAIT_L(0); PG8_BAR; PG8_MMA(1, 0, At, B0); PG8_MMA(1, 1, At, B1); PG8_BAR; PG8_SCHED;
            PG8_LDB(B0, 1, 0); PG8_LDB(B1, 1, 1); PG8_SCHED; PG8_LDA(At, 1, 0); PG8_STAGE(PG8_SA(0, 1), a2 + hstep, voffA);
            PG8_WAIT_V(8); PG8_WAIT_L(0); PG8_BAR; PG8_MMA(0, 0, At, B0); PG8_MMA(0, 1, At, B1); PG8_BAR; PG8_SCHED;
            PG8_LDA(At, 1, 1); PG8_STAGE(PG8_SB(1, 0), b3, voffB); PG8_STAGE(PG8_SB(1, 1), b3 + hstep, voffB); PG8_STAGE(PG8_SA(1, 0), a3, voffA);
            PG8_WAIT_V(8); PG8_WAIT_L(0); PG8_BAR; PG8_MMA(1, 0, At, B0); PG8_MMA(1, 1, At, B1); PG8_BAR; PG8_SCHED;
            } else {
            PG8_LDB(B0, 0, 0); PG8_SCHED; PG8_LDA(At, 0, 0); PG8_STAGE(PG8_SA(1, 1), a1 + hstep, voffA);
            PG8_WAIT_L(8); PG8_BAR; PG8_WAIT_L(0); PG8_MMA(0, 0, At, B0); PG8_BAR; PG8_SCHED;
            PG8_LDB(B1, 0, 1); PG8_STAGE(PG8_SB(0, 0), b2, voffB);
            PG8_BAR; PG8_WAIT_L(0); PG8_MMA(0, 1, At, B1); PG8_BAR;
            PG8_LDA(At, 0, 1); PG8_STAGE(PG8_SA(0, 0), a2, voffA);
            PG8_BAR; PG8_WAIT_L(0); PG8_MMA(1, 0, At, B0); PG8_BAR; PG8_SCHED;
            PG8_STAGE(PG8_SB(0, 1), b2 + hstep, voffB);
            PG8_WAIT_V(6); PG8_BAR; PG8_MMA(1, 1, At, B1); PG8_BAR;
            PG8_LDB(B0, 1, 0); PG8_SCHED; PG8_LDA(At, 1, 0); PG8_STAGE(PG8_SA(0, 1), a2 + hstep, voffA);
            PG8_WAIT_L(8); PG8_BAR; PG8_WAIT_L(0); PG8_MMA(0, 0, At, B0); PG8_BAR; PG8_SCHED;
            PG8_LDB(B1, 1, 1); PG8_STAGE(PG8_SB(1, 0), b3, voffB);
            PG8_BAR; PG8_WAIT_L(0); PG8_MMA(0, 1, At, B1); PG8_BAR;
            PG8_LDA(At, 1, 1); PG8_STAGE(PG8_SA(1, 0), a3, voffA);
            PG8_BAR; PG8_WAIT_L(0); PG8_MMA(1, 0, At, B0); PG8_BAR; PG8_SCHED;
            PG8_STAGE(PG8_SB(1, 1), b3 + hstep, voffB);
            PG8_WAIT_V(6); PG8_BAR; PG8_MMA(1, 1, At, B1); PG8_BAR;
            }
        }
        if constexpr (ALIGN_EPI) { if (wr == 0) PG8_BAR; }
        if constexpr (!Epi::AFTER_DRAIN) { E(acc, cur, wr, wc, fr, fq); S.done(cur); }
        if (!has_next) break;
#pragma unroll
        for (int a = 0; a < 2; ++a)
#pragma unroll
            for (int b = 0; b < 2; ++b)
#pragma unroll
                for (int m = 0; m < 4; ++m)
#pragma unroll
                    for (int n = 0; n < 2; ++n) acc[a][b][m][n] = (f32x4){0.f, 0.f, 0.f, 0.f};
        cur = nxt; cA = nA; cB = nB; ++ui;
        if constexpr (ALIGN_EPI) { if (wr == 1) PG8_BAR; }
    }
    PG8_WAIT_V(0);
    if constexpr (!ALIGN_EPI) { if (wr == 0) PG8_BAR; }
    PG8_BAR;
    if constexpr (Epi::AFTER_DRAIN) { E.fused(acc, cur, wr, wc, fr, fq, lds, wid, lane); S.done(cur); }
#undef PG8_SA
#undef PG8_SB
#undef PG8_STAGE
#undef PG8_LDA
#undef PG8_LDB
#undef PG8_MMA
#undef PG8_WAIT_V
#undef PG8_WAIT_L
#undef PG8_BAR
#undef PG8_SCHED
}
}
#include <hip/hip_bf16.h>
#include <cmath>
namespace attn_body {
using bf16=__hip_bfloat16;
using bf16x8=__attribute__((ext_vector_type(8)))short;
using s16x4=__attribute__((ext_vector_type(4)))short;
using f32x16=__attribute__((ext_vector_type(16)))float;
using u32x4=__attribute__((ext_vector_type(4)))unsigned;
constexpr int BATCH=16,NHEAD=8,SEQ=2048,D=64,PQ=512,PO=1024;
constexpr int NW=8,QBLK=32,QB=QBLK*NW,KVBLK=64,NQB=SEQ/QB;
__device__ __forceinline__ int crow(int r,int hi){return (r&3)+8*(r>>2)+4*hi;}
#define SBAR() __builtin_amdgcn_sched_barrier(0)
__device__ __forceinline__ void cmask(f32x16&p0,f32x16&p1,int jb,int qrel,int hi){
  const float NEG=-INFINITY; int kb=64*jb+4*hi;
  #pragma unroll
  for(int r=0;r<16;++r){int kv=kb+(r&3)+8*(r>>2); if(kv>qrel)p0[r]=NEG; if(kv+32>qrel)p1[r]=NEG;}
}

constexpr int NSLOT=3, SLOTB=8192;
constexpr int LDS_K=0, LDS_V=NSLOT*SLOTB, LDS_WS=2*NSLOT*SLOTB, LDS_OST=LDS_WS+NW*64*4, LDS_BYTES=LDS_OST+NW*4096;
constexpr float C2=0.125f*1.4426950408889634f;
__device__ __forceinline__ void glds16(const void*gsrc,unsigned lds_dst){unsigned keep;
  asm volatile("s_mov_b32 %0, m0\n\ts_mov_b32 m0, %2\n\ts_nop 0\n\tglobal_load_lds_dwordx4 %1, off\n\ts_mov_b32 m0, %0":"=&s"(keep):"v"(gsrc),"s"(lds_dst):"memory");}
__device__ __forceinline__ float max3f(float a,float b,float c){float r;asm("v_max3_f32 %0, %1, %2, %3":"=v"(r):"v"(a),"v"(b),"v"(c));return r;}
__device__ __forceinline__ float max2f(float a,float b){float r;asm("v_max_f32_e32 %0, %1, %2":"=v"(r):"v"(a),"v"(b));return r;}
__device__ __forceinline__ float fadd_s(float a,float b){float r;asm("v_add_f32_e32 %0, %1, %2":"=v"(r):"v"(a),"v"(b));return r;}
__device__ __forceinline__ float fsub_s(float a,float b){float r;asm("v_sub_f32_e32 %0, %1, %2":"=v"(r):"v"(a),"v"(b));return r;}
typedef float f32x4g __attribute__((ext_vector_type(4)));
__device__ __forceinline__ float bfv(short v){return __uint_as_float(((unsigned)(unsigned short)v)<<16);}
typedef float f32x2_t __attribute__((ext_vector_type(2))); typedef __bf16 bf16x2_t __attribute__((ext_vector_type(2)));
__device__ __forceinline__ unsigned cvtpk_s(float lo,float hi){f32x2_t v={lo,hi};bf16x2_t b=__builtin_convertvector(v,bf16x2_t);return __builtin_bit_cast(unsigned,b);}
#define WAIT_BAR(N) asm volatile("s_waitcnt vmcnt(" #N ") lgkmcnt(0)\n\ts_barrier":::"memory")

__device__ __forceinline__ void qkt(f32x16&p0,f32x16&p1,const char*Kslot,const bf16x8*qr,int r32,int hi){
  const char*kb=Kslot+hi*1024+r32*16;
  #pragma unroll
  for(int d0=0;d0<4;++d0){
    const bf16x8 b0=*reinterpret_cast<const bf16x8*>(kb+d0*2048);
    const bf16x8 b1=*reinterpret_cast<const bf16x8*>(kb+d0*2048+512);
    p0=__builtin_amdgcn_mfma_f32_32x32x16_bf16(b0,qr[d0],p0,0,0,0);p1=__builtin_amdgcn_mfma_f32_32x32x16_bf16(b1,qr[d0],p1,0,0,0);}
}
typedef __attribute__((address_space(3))) const char* lds_cptr;
typedef short v4i16_t __attribute__((ext_vector_type(4)));
__device__ __forceinline__ void kload8(bf16x8*kf,lds_cptr kp){
  kf[0]=*(const __attribute__((address_space(3))) bf16x8*)(kp);      kf[1]=*(const __attribute__((address_space(3))) bf16x8*)(kp+512);
  kf[2]=*(const __attribute__((address_space(3))) bf16x8*)(kp+2048); kf[3]=*(const __attribute__((address_space(3))) bf16x8*)(kp+2560);
  kf[4]=*(const __attribute__((address_space(3))) bf16x8*)(kp+4096); kf[5]=*(const __attribute__((address_space(3))) bf16x8*)(kp+4608);
  kf[6]=*(const __attribute__((address_space(3))) bf16x8*)(kp+6144); kf[7]=*(const __attribute__((address_space(3))) bf16x8*)(kp+6656);
}
__device__ __forceinline__ void kload2(bf16x8*kf,lds_cptr kp,int j){ kf[2*j]=*(const __attribute__((address_space(3))) bf16x8*)(kp+j*2048); kf[2*j+1]=*(const __attribute__((address_space(3))) bf16x8*)(kp+j*2048+512); }
__device__ __forceinline__ s16x4 vtr(lds_cptr p){ return __builtin_bit_cast(s16x4,__builtin_amdgcn_ds_read_tr16_b64_v4i16((__attribute__((address_space(3))) v4i16_t*)p)); }
__device__ __forceinline__ float rowmax(const f32x16&p0,const f32x16&p1){
  float a=max3f(p0[0],p0[1],p1[0]),b=max3f(p0[2],p0[3],p1[1]);a=max3f(a,p1[2],p1[3]);
  #pragma unroll
  for(int r=4;r<16;r+=4){a=max3f(a,p0[r],p0[r+1]);b=max3f(b,p0[r+2],p0[r+3]);a=max3f(a,p1[r],p1[r+1]);b=max3f(b,p1[r+2],p1[r+3]);}
  const float m=max2f(a,b);
  auto rr=__builtin_amdgcn_permlane32_swap(__float_as_uint(m),__float_as_uint(m),false,false);
  return max2f(__uint_as_float(rr[0]),__uint_as_float(rr[1]));
}
__device__ __forceinline__ void pv(f32x16*o,int vb,bf16x8 pa0,bf16x8 pa1,bf16x8 pa2,bf16x8 pa3){
  #pragma unroll
  for(int d0=0;d0<2;++d0){s16x4 lo[4],hi[4];
    #pragma unroll
    for(int ks=0;ks<4;++ks){
      asm volatile("ds_read_b64_tr_b16 %0,%1 offset:%c2":"=&v"(lo[ks]):"v"(vb),"i"(d0*4096+ks*1024):"memory");
      asm volatile("ds_read_b64_tr_b16 %0,%1 offset:%c2":"=&v"(hi[ks]):"v"(vb),"i"(d0*4096+ks*1024+512):"memory");}
    asm volatile("s_waitcnt lgkmcnt(0)":::"memory");SBAR();
    #define PK(k) (bf16x8){lo[k][0],lo[k][1],lo[k][2],lo[k][3],hi[k][0],hi[k][1],hi[k][2],hi[k][3]}
    o[d0]=__builtin_amdgcn_mfma_f32_32x32x16_bf16(pa0,PK(0),o[d0],0,0,0);
    o[d0]=__builtin_amdgcn_mfma_f32_32x32x16_bf16(pa1,PK(1),o[d0],0,0,0);
    o[d0]=__builtin_amdgcn_mfma_f32_32x32x16_bf16(pa2,PK(2),o[d0],0,0,0);
    o[d0]=__builtin_amdgcn_mfma_f32_32x32x16_bf16(pa3,PK(3),o[d0],0,0,0);
    #undef PK
  }
}

#ifndef ATTN_STORE16
#define ATTN_STORE16(p,v) (*(u32x4*)(p)=(v))
#endif
template<int THRL> __device__ __forceinline__ void attn_unit(int b,int h,int qb,const bf16*Q,const bf16*__restrict__ K,const bf16*__restrict__ V,bf16*O,float*SSQ,const float*__restrict__ KM,char*shm,const int wv){
  int tid_=wv*64+(int)__builtin_amdgcn_mbcnt_hi(~0u,__builtin_amdgcn_mbcnt_lo(~0u,0u)); asm volatile("":"+v"(tid_)); const int tid=tid_,lane=tid&63,r32=lane&31,hi=lane>>5; const int wid=__builtin_amdgcn_readfirstlane(tid>>6);
  const long rowbase=(long)b*SEQ; const int q0=qb*QB;
  const bf16*Qw=Q+(rowbase+q0+wid*QBLK)*PQ+h*D;
  const bf16*Kh=K+rowbase*PQ+h*D,*Vh=V+rowbase*PQ+h*D;
  const unsigned lds0=(unsigned)(uintptr_t)shm;
  float*wsf=(float*)(shm+LDS_WS)+wid*64;
  const bf16*ksrc=Kh+(long)lane*PQ+wid*8;
  const bf16*vsrc=Vh+(long)(16*(wid&3)+(lane>>2))*PQ+(wid>>2)*32+(lane&3)*8;
  const unsigned kdst=lds0+LDS_K+wid*1024, vdst=lds0+LDS_V+wid*1024;
  #define KT(t) (((t)<4)?(4*qb+(t)):((t)-4))
  #define DMA_K(t,slot) glds16(ksrc+(long)KT(t)*KVBLK*PQ,(unsigned)__builtin_amdgcn_readfirstlane(kdst+(slot)))
  #define DMA_V(t,slot) glds16(vsrc+(long)KT(t)*KVBLK*PQ,(unsigned)__builtin_amdgcn_readfirstlane(vdst+(slot)))
  const int vb0=(int)(lds0+LDS_V)+((lane>>4)&1)*32+(lane&3)*8+(4*hi+((lane&15)>>2))*64;
  const char*Kbase=shm+LDS_K; bf16x8 kf[8];
  const lds_cptr shm3=(lds_cptr)shm; const lds_cptr kp0=shm3+LDS_K+hi*1024+r32*16; const lds_cptr vp0=shm3+LDS_V+((lane>>4)&1)*32+(lane&3)*8+(4*hi+((lane&15)>>2))*64;
  const int NT=(q0+QB)/KVBLK;
  DMA_K(0,0);DMA_V(0,0);DMA_K(1,SLOTB);
  bf16x8 qr[4];
  #pragma unroll
  for(int d0=0;d0<4;++d0)qr[d0]=*reinterpret_cast<const bf16x8*>(&Qw[(long)r32*PQ+d0*16+hi*8]);
  unsigned selm=0u;
  if(qb>0){ float gsc[7];
    #pragma unroll
    for(int n=0;n<7;++n){ float a=0.f;
      if(n<qb){ const float*km=KM+((long)((b*NHEAD+h)*NQB+n))*D+8*hi;
        #pragma unroll
        for(int d0=0;d0<4;++d0){ const f32x4g k0=*(const f32x4g*)(km+16*d0), k1=*(const f32x4g*)(km+16*d0+4);
          a+=bfv(qr[d0][0])*k0[0]+bfv(qr[d0][1])*k0[1]+bfv(qr[d0][2])*k0[2]+bfv(qr[d0][3])*k0[3]+bfv(qr[d0][4])*k1[0]+bfv(qr[d0][5])*k1[1]+bfv(qr[d0][6])*k1[2]+bfv(qr[d0][7])*k1[3]; } }
      {auto rr_=__builtin_amdgcn_permlane32_swap(__float_as_uint(a),__float_as_uint(a),false,false); a=__uint_as_float(rr_[0])+__uint_as_float(rr_[1]);} gsc[n]=(n<qb)?a:-INFINITY; }
    #pragma unroll
    for(int k=0;k<3;++k){ int best=-1; float bv=-INFINITY;
      #pragma unroll
      for(int n=0;n<7;++n) if(!((selm>>n)&1u)&&gsc[n]>bv){bv=gsc[n];best=n;}
      if(best>=0)selm|=1u<<best; } }
  const float sl2=__builtin_amdgcn_exp2f(-(float)(h+1))*1.4426950408889634f, sl32=32.f*sl2, cbase=(float)(4*hi)*sl2;
  float mhat=0.f,l_reg=0.f;f32x16 o[2];o[0]=f32x16{};o[1]=f32x16{};
  #define CIN(C0,C1,t) do{ float cl_=cbase+(float)(KT(t)*KVBLK-q0)*sl2-mhat; if((t)>=4){ if(!((selm>>(((t)>=4?(t)-4:0)>>2))&1u)) cl_=-INFINITY; } const float cl1_=cl_+sl32; \
    _Pragma("unroll") for(int r=0;r<16;++r){C0[r]=__builtin_fmaf(sl2,(float)((r&3)+8*(r>>2)),cl_);C1[r]=__builtin_fmaf(sl2,(float)((r&3)+8*(r>>2)),cl1_);} }while(0)
  const int qrel=wid*QBLK+r32;
  #define CMASK(P0,P1,t) do{ if((t)<4)cmask(P0,P1,(t),qrel,hi); }while(0)
  bool resc=false;
  #define START(P0,P1) do{ const float rm=rowmax(P0,P1); resc=false; \
    { const float dl=rm; mhat=fadd_s(mhat,dl); \
      _Pragma("unroll") for(int r=0;r<16;++r){P0[r]=fsub_s(P0[r],dl);P1[r]=fsub_s(P1[r],dl);} } \
    _Pragma("unroll") for(int r=0;r<16;++r)P0[r]=__builtin_amdgcn_exp2f(P0[r]); }while(0)
  #define RESC() do{ if(resc){ asm volatile("s_waitcnt lgkmcnt(0)":::"memory"); \
      _Pragma("unroll") for(int d_=0;d_<2;++d_) _Pragma("unroll") for(int r=0;r<16;++r)o[d_][r]*=wsf[crow(r,hi)]; } }while(0)
  f32x16 pA0,pA1,pB0,pB1;
  int sl_prev=0,sl_cur=0,sl_next=SLOTB;
  #define ROT() do{sl_prev=sl_cur;sl_cur=sl_next;sl_next=(sl_next==(NSLOT-1)*SLOTB)?0:sl_next+SLOTB;}while(0)
  DMA_K(2,2*SLOTB);
  WAIT_BAR(3);
  CIN(pA0,pA1,0); qkt(pA0,pA1,Kbase,qr,r32,hi);asm volatile("s_nop 15\n\ts_nop 7":"+v"(pA0),"+v"(pA1));CMASK(pA0,pA1,0);
  START(pA0,pA1);
  _Pragma("unroll") for(int r=0;r<16;++r)pA1[r]=__builtin_amdgcn_exp2f(pA1[r]);
  WAIT_BAR(0);
  DMA_K(3,0);DMA_V(1,SLOTB);
  ROT();
  kload8(kf,kp0+sl_cur);
  WAIT_BAR(2);
  s16x4 vlo[8],vhi[8]; u32x4 pw0,pw1,pw2,pw3;
  #define PKW(P,B) cvtpk_s(P[B],P[B+1])
  #define PAF(k) __builtin_bit_cast(bf16x8,pw##k)
  #define VFR(i) (bf16x8){vlo[i][0],vlo[i][1],vlo[i][2],vlo[i][3],vhi[i][0],vhi[i][1],vhi[i][2],vhi[i][3]}
  #define PIN(x) asm volatile("":"+v"(x))
  #define MX3(a,b,c) __builtin_fmaxf(__builtin_fmaxf((a),(b)),(c))
  #define GAPA(MF,A0,A1,A2,A3,W0,W1,PW) do{ MF; sacc+=A0; sacc+=A1; sacc+=A2; sacc+=A3; PIN(sacc); W0; W1; PIN(PW); SBAR(); }while(0)
  #define EX(v) __builtin_amdgcn_exp2f(v)
  #define GAPB(MF,X,B) do{ MF; X[B]=EX(X[B]); X[B+1]=EX(X[B+1]); X[B+2]=EX(X[B+2]); X[B+3]=EX(X[B+3]); PIN(X); SBAR(); }while(0)
  #define VRD(i) do{ vlo[i]=vtr(vp_+(((i)>>2)*4096+((i)&3)*1024)); vhi[i]=vtr(vp_+(((i)>>2)*4096+((i)&3)*1024+512)); }while(0)
  #define KRD(G,j) do{ if(G){ kload2(kf,kp0+sl_next,j); SBAR(); } }while(0)
  #define STEP(C0,C1,P0,P1,t,GK,GV,GL) do{ SBAR(); CIN(C0,C1,t); SBAR(); \
    const lds_cptr vp_=vp0+sl_prev; \
    VRD(0); SBAR(); float sacc=(P0[0]+P0[1]); \
    GAPA(C0=__builtin_amdgcn_mfma_f32_32x32x16_bf16(kf[0],qr[0],C0,0,0,0), P0[2],P0[3],P0[4],P0[5],     pw0[0]=PKW(P0,0), pw0[1]=PKW(P0,2), pw0); \
    VRD(4); SBAR(); GAPA(C1=__builtin_amdgcn_mfma_f32_32x32x16_bf16(kf[1],qr[0],C1,0,0,0), P0[6],P0[7],P0[8],P0[9],     pw0[2]=PKW(P0,4), pw0[3]=PKW(P0,6), pw0); \
    VRD(1); SBAR(); GAPA(C0=__builtin_amdgcn_mfma_f32_32x32x16_bf16(kf[2],qr[1],C0,0,0,0),   P0[10],P0[11],P0[12],P0[13], pw1[0]=PKW(P0,8), pw1[1]=PKW(P0,10), pw1); \
    VRD(5); SBAR(); GAPA(C1=__builtin_amdgcn_mfma_f32_32x32x16_bf16(kf[3],qr[1],C1,0,0,0),   P0[14],P0[15],P1[0],P1[1],   pw1[2]=PKW(P0,12),pw1[3]=PKW(P0,14), pw1); \
    VRD(2); SBAR(); GAPA(C0=__builtin_amdgcn_mfma_f32_32x32x16_bf16(kf[4],qr[2],C0,0,0,0),   P1[2],P1[3],P1[4],P1[5],     pw2[0]=PKW(P1,0), pw2[1]=PKW(P1,2), pw2); \
    VRD(6); SBAR(); GAPA(C1=__builtin_amdgcn_mfma_f32_32x32x16_bf16(kf[5],qr[2],C1,0,0,0),   P1[6],P1[7],P1[8],P1[9],     pw2[2]=PKW(P1,4), pw2[3]=PKW(P1,6), pw2); \
    VRD(3); SBAR(); GAPA(C0=__builtin_amdgcn_mfma_f32_32x32x16_bf16(kf[6],qr[3],C0,0,0,0),   P1[10],P1[11],P1[12],P1[13], pw3[0]=PKW(P1,8), pw3[1]=PKW(P1,10), pw3); \
    VRD(7); SBAR(); GAPA(C1=__builtin_amdgcn_mfma_f32_32x32x16_bf16(kf[7],qr[3],C1,0,0,0),   P1[14],P1[15],0.f,0.f,       pw3[2]=PKW(P1,12),pw3[3]=PKW(P1,14), pw3); \
    l_reg+=sacc; \
    if(GK){DMA_K((t)+3,sl_cur);} if(GV){DMA_V((t)+1,sl_next);} \
    CMASK(C0,C1,t); \
    { float a=MX3(C0[0],C0[1],C1[0]),b=MX3(C0[2],C0[3],C1[1]); a=MX3(a,C1[2],C1[3]); \
      _Pragma("unroll") for(int r=4;r<16;r+=4){a=MX3(a,C0[r],C0[r+1]);b=MX3(b,C0[r+2],C0[r+3]);a=MX3(a,C1[r],C1[r+1]);b=MX3(b,C1[r+2],C1[r+3]);} \
      float rm=__builtin_fmaxf(a,b); { auto rr=__builtin_amdgcn_permlane32_swap(__float_as_uint(rm),__float_as_uint(rm),false,false); rm=__builtin_fmaxf(__uint_as_float(rr[0]),__uint_as_float(rr[1])); } \
      resc=false; \
      if(__builtin_expect(__any(rm>(float)THRL),0)){ const float dl=__builtin_fmaxf(rm,0.f); mhat+=dl; \
        _Pragma("unroll") for(int r=0;r<16;++r){C0[r]-=dl;C1[r]-=dl;} \
        const float f=__builtin_amdgcn_exp2f(-dl); l_reg*=f; if(hi==0)wsf[r32]=f; resc=true; } } \
    SBAR(); \
    GAPB(o[0]=__builtin_amdgcn_mfma_f32_32x32x16_bf16(PAF(0),VFR(0),o[0],0,0,0), C0,0); \
    GAPB(o[1]=__builtin_amdgcn_mfma_f32_32x32x16_bf16(PAF(0),VFR(4),o[1],0,0,0), C0,4); \
    KRD(GL,0); GAPB(o[0]=__builtin_amdgcn_mfma_f32_32x32x16_bf16(PAF(1),VFR(1),o[0],0,0,0), C0,8); \
    KRD(GL,1); GAPB(o[1]=__builtin_amdgcn_mfma_f32_32x32x16_bf16(PAF(1),VFR(5),o[1],0,0,0), C0,12); \
    KRD(GL,2); GAPB(o[0]=__builtin_amdgcn_mfma_f32_32x32x16_bf16(PAF(2),VFR(2),o[0],0,0,0), C1,0); \
    KRD(GL,3); GAPB(o[1]=__builtin_amdgcn_mfma_f32_32x32x16_bf16(PAF(2),VFR(6),o[1],0,0,0), C1,4); \
    GAPB(o[0]=__builtin_amdgcn_mfma_f32_32x32x16_bf16(PAF(3),VFR(3),o[0],0,0,0), C1,8); \
    GAPB(o[1]=__builtin_amdgcn_mfma_f32_32x32x16_bf16(PAF(3),VFR(7),o[1],0,0,0), C1,12); \
    }while(0)
  int t=1;
  #define ENDW(tt) do{ if((tt)+3<NT){WAIT_BAR(2);} else if((tt)+2<NT){WAIT_BAR(1);} else {WAIT_BAR(0);} }while(0)
  for(;t+1<NT;t+=2){
    STEP(pB0,pB1,pA0,pA1,t,(t+3<NT),(t+1<NT),(t+1<NT));       ENDW(t);   RESC(); ROT();
    STEP(pA0,pA1,pB0,pB1,t+1,(t+4<NT),(t+2<NT),(t+2<NT));     ENDW(t+1); RESC(); ROT();
  }
  STEP(pB0,pB1,pA0,pA1,NT-1,false,false,false); RESC();
  { float sacc=pB0[0]+pB0[1]; _Pragma("unroll") for(int r=2;r<16;++r)sacc+=pB0[r]; _Pragma("unroll") for(int r=0;r<16;++r)sacc+=pB1[r]; l_reg+=sacc;
    pw0=(u32x4){PKW(pB0,0),PKW(pB0,2),PKW(pB0,4),PKW(pB0,6)};pw1=(u32x4){PKW(pB0,8),PKW(pB0,10),PKW(pB0,12),PKW(pB0,14)};pw2=(u32x4){PKW(pB1,0),PKW(pB1,2),PKW(pB1,4),PKW(pB1,6)};pw3=(u32x4){PKW(pB1,8),PKW(pB1,10),PKW(pB1,12),PKW(pB1,14)};
    SBAR(); pv(o,vb0+sl_cur,PAF(0),PAF(1),PAF(2),PAF(3)); }
  #undef PKW
  #undef PAF
  #undef VFR
  #undef PIN
  #undef MX3
  #undef GAPA
  #undef GAPB
  #undef EX
  #undef VRD
  #undef KRD
  #undef STEP
  #undef ENDW
  {auto rr=__builtin_amdgcn_permlane32_swap(__float_as_uint(l_reg),__float_as_uint(l_reg),false,false);l_reg=__uint_as_float(rr[0])+__uint_as_float(rr[1]);}
  if(hi==0)wsf[32+r32]=l_reg;asm volatile("s_waitcnt lgkmcnt(0)":::"memory");
  float rli[16];
  #pragma unroll
  for(int r=0;r<16;++r)rli[r]=__builtin_amdgcn_rcpf(wsf[32+crow(r,hi)]);
  bf16*Ow=O+(rowbase+q0+wid*QBLK)*PO+h*D; float*Sw=SSQ+(rowbase+q0+wid*QBLK)*NHEAD+h;
  { bf16*stg=(bf16*)(shm+LDS_OST)+wid*2048;
    #pragma unroll
    for(int r=0;r<16;++r){const int orow=crow(r,hi);
      #pragma unroll
      for(int d0=0;d0<2;++d0)stg[orow*64+d0*32+r32]=__float2bfloat16(o[d0][r]*rli[r]);}
    asm volatile("s_waitcnt lgkmcnt(0)":::"memory");
    #pragma unroll
    for(int i=0;i<4;++i){const int row=i*8+(lane>>3),ch=lane&7; const u32x4 v=*(const u32x4*)(stg+row*64+ch*8); ATTN_STORE16(Ow+(long)row*PO+ch*8,v);
      float ss=0.f;
      #pragma unroll
      for(int k=0;k<4;++k){const float lo=__uint_as_float(v[k]<<16),hh=__uint_as_float(v[k]&0xffff0000u); ss+=lo*lo+hh*hh;}
      ss+=__uint_as_float((unsigned)__builtin_amdgcn_ds_swizzle((int)__float_as_uint(ss),(1<<10)|0x1f));ss+=__uint_as_float((unsigned)__builtin_amdgcn_ds_swizzle((int)__float_as_uint(ss),(2<<10)|0x1f));ss+=__uint_as_float((unsigned)__builtin_amdgcn_ds_swizzle((int)__float_as_uint(ss),(4<<10)|0x1f)); if(ch==0)Sw[(long)row*NHEAD]=ss;} }
  asm volatile("s_waitcnt lgkmcnt(0)\n\ts_barrier":::"memory");
  #undef DMA_K
  #undef KT
  #undef CIN
  #undef DMA_V
  #undef CMASK
  #undef START
  #undef RESC
  #undef ROT
}
constexpr int ATTN_LDS_BYTES=LDS_BYTES;
struct AttnTensors { const bf16* Q; const bf16* K; const bf16* V; bf16* O; float* SSQ; const float* KM; };
struct AttnUnit { int bh; int qb; };
struct MobaOrder {
  int vcu,G;
  __device__ __forceinline__ explicit MobaOrder(int grid,int block):vcu((grid%8==0)?(block%8)*(grid/8)+block/8:block),G(grid){}
  __device__ __forceinline__ bool next(int i,AttnUnit&u)const{ const int L=(i>>2)*G+vcu; if(L>=BATCH*NHEAD*2)return false; const int s=2*(L&1)+((i>>1)&1); u.bh=L>>1; u.qb=(i&1)?7-s:s; return true; }
};
template<class Sched,int THRL=8> __device__ __forceinline__ void attn_phase(char*lds,const AttnTensors&T,const Sched&S,const int wv){
  AttnUnit u;
  for(int i=0;S.next(i,u);++i){ attn_unit<THRL>(u.bh/NHEAD,u.bh%NHEAD,u.qb,T.Q,T.K,T.V,T.O,T.SSQ,T.KM,lds,wv); }
}
#undef SBAR
#undef WAIT_BAR
}
#define GAS __attribute__((address_space(1)))
#define LAS __attribute__((address_space(3)))
typedef unsigned short bf16;
typedef unsigned v4u __attribute__((ext_vector_type(4)));
typedef float f32x4 __attribute__((ext_vector_type(4)));
typedef short bf16x8 __attribute__((ext_vector_type(8)));
typedef GAS unsigned gu32;
typedef GAS unsigned long long gu64;
#define RLX_AGENT __ATOMIC_RELAXED, __HIP_MEMORY_SCOPE_AGENT
__device__ __forceinline__ int hw_lane() { return (int)__builtin_amdgcn_mbcnt_hi(~0u, __builtin_amdgcn_mbcnt_lo(~0u, 0u)); }
template <int K> __device__ __forceinline__ float xadd(float v) {
    if constexpr (K < 32) return v + __uint_as_float((unsigned)__builtin_amdgcn_ds_swizzle((int)__float_as_uint(v), (K << 10) | 0x1f));
    else { auto rr = __builtin_amdgcn_permlane32_swap(__float_as_uint(v), __float_as_uint(v), false, false); return __uint_as_float(rr[0]) + __uint_as_float(rr[1]); }
}
template <int K> __device__ __forceinline__ float xmax(float v) {
    if constexpr (K < 32) return fmaxf(v, __uint_as_float((unsigned)__builtin_amdgcn_ds_swizzle((int)__float_as_uint(v), (K << 10) | 0x1f)));
    else { auto rr = __builtin_amdgcn_permlane32_swap(__float_as_uint(v), __float_as_uint(v), false, false); return fmaxf(__uint_as_float(rr[0]), __uint_as_float(rr[1])); }
}
#define LDS_WAIT() asm volatile("s_waitcnt lgkmcnt(0)" ::: "memory")
#define VM_WAIT() asm volatile("s_waitcnt vmcnt(0)" ::: "memory")
__device__ __forceinline__ unsigned long long rt() { return __builtin_amdgcn_s_memrealtime(); }
__device__ __forceinline__ unsigned f2bf(float f) { unsigned u = __builtin_bit_cast(unsigned, f); return (u + 0x7fffu + ((u >> 16) & 1u)) >> 16; }
__device__ __forceinline__ unsigned pk2(float lo, float hi) { return f2bf(lo) | (f2bf(hi) << 16); }

#define XB_TMO      128
#define XB_XCNT(j)  (256  + 64 * (j))
#define XB_XSUB(j)  (1280 + 64 * (j))
#define XB_XGEN(j)  (2304 + 64 * (j))
#define XB_TOP      3328
#define XB_TOPGEN   3392
#define XCD_BAR_WORDS 3456
#define XB_SPIN_CAP (1u << 18)

__device__ __forceinline__ unsigned xb_ld(unsigned* p)              { return __hip_atomic_load(p, __ATOMIC_RELAXED, __HIP_MEMORY_SCOPE_AGENT); }
__device__ __forceinline__ unsigned xb_add(unsigned* p, unsigned v) { return __hip_atomic_fetch_add(p, v, __ATOMIC_RELAXED, __HIP_MEMORY_SCOPE_AGENT); }
__device__ __forceinline__ unsigned xb_xcc_id() { return (unsigned)__builtin_amdgcn_s_getreg((3 << 11) | 20) & 0xFu; }
#define XB_SPIN(cond, bar) do { unsigned _sp = 0; while (cond) { __builtin_amdgcn_s_sleep(1); \
    if ((++_sp & 255u) == 0u) { if (xb_ld(&(bar)[XB_TMO])) break; if (_sp > XB_SPIN_CAP) { atomicAdd(&(bar)[XB_TMO], 1u); break; } } } } while (0)

struct XcdBarrier {
    unsigned* bar; unsigned x;
    volatile LAS unsigned* st;
};

__device__ __forceinline__ XcdBarrier xcd_barrier_post(unsigned* bar, volatile LAS unsigned* st, bool leader) {
    XcdBarrier b; b.bar = bar; b.x = xb_xcc_id(); b.st = st;
    if (leader) (void)xb_add(&bar[XB_XCNT(b.x)], 1u);
    return b;
}
__device__ __forceinline__ void xcd_barrier_complete(unsigned* bar, unsigned x, unsigned& nloc, unsigned& nx) {
    const unsigned G = gridDim.x * gridDim.y * gridDim.z;
    unsigned sum, cnt, mine, sp = 0u;
    for (;;) {
        sum = 0u; cnt = 0u; mine = 0u;
#pragma unroll
        for (unsigned j = 0; j < 16; ++j) { const unsigned c = xb_ld(&bar[XB_XCNT(j)]); sum += c; cnt += (c > 0u) ? 1u : 0u; mine = (j == x) ? c : mine; }
        if (sum == G) break;
        __builtin_amdgcn_s_sleep(1);
        if ((++sp & 255u) == 0u) { if (xb_ld(&bar[XB_TMO])) break; if (sp > XB_SPIN_CAP) { atomicAdd(&bar[XB_TMO], 1u); break; } }
    }
    nloc = mine > 0u ? mine : 1u; nx = cnt > 0u ? cnt : 1u;
}

__device__ __forceinline__ void xcd_barrier(const XcdBarrier& b, bool leader) {
    asm volatile("s_waitcnt vmcnt(0)" ::: "memory");
    __syncthreads();
    if (leader) {
        unsigned* bar = b.bar;
        __builtin_amdgcn_s_waitcnt(0);
        unsigned nloc = b.st[0], nx = b.st[1];
        if (nloc == 0u) { xcd_barrier_complete(bar, b.x, nloc, nx); b.st[0] = nloc; b.st[1] = nx; }
        const unsigned old = xb_add(&bar[XB_XSUB(b.x)], 1u);
        const unsigned gen = old / nloc;
        if (old + 1u == (gen + 1u) * nloc) {
            __builtin_amdgcn_fence(__ATOMIC_RELEASE, "agent");
            asm volatile("s_waitcnt vmcnt(0)" ::: "memory");
            const unsigned og = xb_add(&bar[XB_TOP], 1u);
            const unsigned tg = og / nx;
            if (og + 1u == (tg + 1u) * nx) xb_add(&bar[XB_TOPGEN], 1u);
            else XB_SPIN(xb_ld(&bar[XB_TOPGEN]) == tg, bar);
            __builtin_amdgcn_fence(__ATOMIC_ACQUIRE, "agent");
            xb_add(&bar[XB_XGEN(b.x)], 1u);
            asm volatile("s_waitcnt vmcnt(0)" ::: "memory");
        } else {
            XB_SPIN(xb_ld(&bar[XB_XGEN(b.x)]) == gen, bar);
            __builtin_amdgcn_fence(__ATOMIC_ACQUIRE, "agent");
            asm volatile("s_waitcnt vmcnt(0)" ::: "memory");
        }
    }
    __syncthreads();
}

constexpr int NWAVES = 8;
constexpr int DM = 1024, BATCH = 16, SEQ = 2048, DEPTH = 2, HD = 64, NH = 8, NGRP = 8, AW = 512, GWD = 512, INW = 2560, MOBA = 256, NBLK = SEQ / MOBA, GCH = 128, DFF = 2816, PLE = 256;
constexpr int M = BATCH * SEQ;
constexpr float RMS_EPS = 1e-6f, LN_EPS = 1e-5f;
constexpr float LOG2E = 1.4426950408889634f;
constexpr float QSCALE = 0.125f * LOG2E;

constexpr size_t MiB = 1u << 20;
constexpr size_t WS_CTL = 0, CTL_ZERO_BYTES = 1 * MiB;
constexpr size_t WL_GU1 = 0, WL_D1 = WL_GU1 + (size_t)2 * DFF * DM * 2, WL_GU2 = WL_D1 + (size_t)DM * DFF * 2, WL_D2 = WL_GU2 + (size_t)2 * DFF * DM * 2,
                 WL_IN = WL_D2 + (size_t)DM * DFF * 2, WL_OUT = WL_IN + (size_t)INW * DM * 2, WL_PG = WL_OUT + (size_t)DM * DM * 2, WL_PP = WL_PG + (size_t)DM * DM * 2, WL_STRIDE = WL_PP + (size_t)DM * PLE * 2;
constexpr size_t WS_W = 2 * MiB;
static_assert(WS_W + 2 * WL_STRIDE <= 88 * MiB, "weights");
constexpr size_t WS_PBF = 88 * MiB;
constexpr size_t WS_XN = 120 * MiB;
constexpr size_t WS_HB = 184 * MiB;
constexpr size_t WS_MRG = 360 * MiB;
constexpr size_t WS_FB = 424 * MiB;
constexpr size_t WS_KM = 488 * MiB;
constexpr size_t WS_WSB = 488 * MiB + 512 * 1024;
constexpr size_t WS_SSQ = 489 * MiB;
constexpr size_t WS_END = 490 * MiB;
constexpr size_t ZSTRIDE = (size_t)M * 512;
static_assert(WS_HB + (size_t)M * DFF * 2 <= WS_MRG && 5 * ZSTRIDE * 2 <= (size_t)M * DFF * 2, "overlay");
constexpr int CW_TMO = 0, CW_CODE = 1, CW_BAR = 4096;

constexpr int RING_OFF = 0, RING_BYTES = 131072;
constexpr int LDSCTL_OFF = RING_BYTES, MISC_OFF = LDSCTL_OFF + 320, EXTRA_OFF = RING_BYTES + 1024;
constexpr int LDS_BYTES = 147456;

struct Frame {
    LAS unsigned char* lds;
    volatile LAS unsigned* MISC;
    gu32* ctl;
    int tid, lane, wave, G;
    float* out; unsigned char* ws;
};
enum { I_X = 0, I_P, I_F1PRE, I_F1G, I_F1U, I_F1D, I_F1POST, I_MIXPRE, I_WIN, I_LNG, I_LNB, I_WS, I_BS, I_AON, I_GON, I_WOUT, I_MIXPOST, I_F2PRE, I_F2G, I_F2U, I_F2D, I_F2POST, I_PLEPRE, I_PLEG, I_PLEP, I_PLEPOST };

__device__ __forceinline__ float wave_sum(float v) { v = xadd<1>(v); v = xadd<2>(v); v = xadd<4>(v); v = xadd<8>(v); v = xadd<16>(v); return xadd<32>(v); }
__device__ __forceinline__ float wave_max(float v) { v = xmax<1>(v); v = xmax<2>(v); v = xmax<4>(v); v = xmax<8>(v); v = xmax<16>(v); return xmax<32>(v); }
__device__ __forceinline__ float bf2f(bf16 b) { return __uint_as_float((unsigned)b << 16); }
__device__ __forceinline__ int fresh_lane() { int l = hw_lane(); asm volatile("" : "+v"(l)); return l; }

__device__ __forceinline__ void p0_transpose_item(const float* W, int K, int N, bf16* WT, LAS float* scr, int k0, int n0, int drow0, const float* gk, int lane) {
#pragma unroll 8
    for (int i = 0; i < 32; ++i) { const int kk = 2 * i + (lane >> 5); const float g = gk ? gk[kk] : 1.0f; scr[kk * 33 + (lane & 31)] = W[(size_t)(k0 + kk) * N + n0 + (lane & 31)] * g; }
    LDS_WAIT(); asm volatile("" ::: "memory");
    const int c = lane & 7;
#pragma unroll
    for (int j = 0; j < 4; ++j) { const int n = (lane >> 3) + 8 * j; const LAS float* s = scr + (8 * c) * 33 + n;
        v4u o; o.x = pk2(s[0 * 33], s[1 * 33]); o.y = pk2(s[2 * 33], s[3 * 33]); o.z = pk2(s[4 * 33], s[5 * 33]); o.w = pk2(s[6 * 33], s[7 * 33]);
        *(GAS v4u*)(WT + (size_t)(drow0 + n) * K + k0 + 8 * c) = o; }
    LDS_WAIT(); asm volatile("" ::: "memory");
}
__device__ __forceinline__ bool p0_matrix(int& r, const float* W, int K, int N, bf16* WT, int mode, const float* gain, const float* gain2, LAS float* scr, int lane) {
    const int nblk = N / 32, items = (K / 64) * nblk;
    if (r >= items) { r -= items; return false; }
    const int kb = r / nblk, nb = r % nblk, k0 = 64 * kb, n0 = 32 * nb;
    const int drow0 = (mode == 0) ? n0 : ((n0 >> 7) * 256 + (n0 & 127) + (mode == 2 ? 128 : 0));
    const float* gk = gain ? ((gain2 && k0 >= 512) ? gain2 + (k0 - 512) : gain + k0) : nullptr;
    p0_transpose_item(W, K, N, WT, scr, k0, n0, drow0, gk, lane);
    return true;
}
__device__ __forceinline__ void rms_row_to_bf16(const float* xrow, bf16* orow, int lane) {
    const GAS f32x4* xr = (const GAS f32x4*)xrow + lane;
    f32x4 v[4]; float s = 0.f;
#pragma unroll
    for (int j = 0; j < 4; ++j) { v[j] = xr[64 * j]; s += (v[j].x * v[j].x + v[j].y * v[j].y) + (v[j].z * v[j].z + v[j].w * v[j].w); }
    const float r = 1.0f / sqrtf(wave_sum(s) * (1.f / DM) + RMS_EPS);
    GAS unsigned long long* o8 = (GAS unsigned long long*)orow + lane;
#pragma unroll
    for (int j = 0; j < 4; ++j) o8[64 * j] = (unsigned long long)pk2(v[j].x * r, v[j].y * r) | ((unsigned long long)pk2(v[j].z * r, v[j].w * r) << 32);
}
struct Args { const float* in[26]; float* out; unsigned char* ws; };
__device__ __forceinline__ void p0_prologue(Frame& F, const Args& A) {
    LAS float* scr = (LAS float*)(F.lds + RING_OFF + F.wave * 16384);
    const int gw = blockIdx.x * NWAVES + F.wave, NGW = F.G * NWAVES;
    constexpr int ITEMS_L = 4 * (DM / 64) * (DFF / 32) + 2 * (DFF / 64) * (DM / 32) + (DM / 64) * (INW / 32) + 2 * (DM / 64) * (DM / 32) + (PLE / 64) * (DM / 32);
    for (int it = gw; it < DEPTH * ITEMS_L; it += NGW) {
        const int l = it / ITEMS_L; int r = it % ITEMS_L;
        bf16* wl = (bf16*)(F.ws + WS_W + (size_t)l * WL_STRIDE);
        if (p0_matrix(r, A.in[I_F1G] + (size_t)l * DM * DFF, DM, DFF, wl + WL_GU1 / 2, 1, A.in[I_F1PRE] + l * DM, nullptr, scr, F.lane)) continue;
        if (p0_matrix(r, A.in[I_F1U] + (size_t)l * DM * DFF, DM, DFF, wl + WL_GU1 / 2, 2, A.in[I_F1PRE] + l * DM, nullptr, scr, F.lane)) continue;
        if (p0_matrix(r, A.in[I_F1D] + (size_t)l * DFF * DM, DFF, DM, wl + WL_D1 / 2, 0, nullptr, nullptr, scr, F.lane)) continue;
        if (p0_matrix(r, A.in[I_F2G] + (size_t)l * DM * DFF, DM, DFF, wl + WL_GU2 / 2, 1, A.in[I_F2PRE] + l * DM, nullptr, scr, F.lane)) continue;
        if (p0_matrix(r, A.in[I_F2U] + (size_t)l * DM * DFF, DM, DFF, wl + WL_GU2 / 2, 2, A.in[I_F2PRE] + l * DM, nullptr, scr, F.lane)) continue;
        if (p0_matrix(r, A.in[I_F2D] + (size_t)l * DFF * DM, DFF, DM, wl + WL_D2 / 2, 0, nullptr, nullptr, scr, F.lane)) continue;
        if (p0_matrix(r, A.in[I_WIN] + (size_t)l * DM * INW, DM, INW, wl + WL_IN / 2, 0, A.in[I_MIXPRE] + l * DM, nullptr, scr, F.lane)) continue;
        if (p0_matrix(r, A.in[I_WOUT] + (size_t)l * DM * DM, DM, DM, wl + WL_OUT / 2, 0, A.in[I_AON] + l * AW, A.in[I_GON] + l * GWD, scr, F.lane)) continue;
        if (p0_matrix(r, A.in[I_PLEG] + (size_t)l * DM * DM, DM, DM, wl + WL_PG / 2, 0, A.in[I_PLEPRE] + l * DM, nullptr, scr, F.lane)) continue;
        p0_matrix(r, A.in[I_PLEP] + (size_t)l * PLE * DM, PLE, DM, wl + WL_PP / 2, 0, nullptr, nullptr, scr, F.lane);
    }
    { const float* wsrc = A.in[I_WS]; bf16* wdst = (bf16*)(F.ws + WS_WSB);
      for (int i = blockIdx.x * (NWAVES * 64) + F.tid; i < DEPTH * NGRP * GCH * GCH; i += F.G * NWAVES * 64) { const int sidx = i & (GCH - 1), tidx = (i >> 7) & (GCH - 1); wdst[i] = (sidx <= tidx) ? (bf16)f2bf(wsrc[i]) : (bf16)0; } }
    { const GAS f32x4* p4 = (const GAS f32x4*)A.in[I_P]; GAS v4u* o = (GAS v4u*)(F.ws + WS_PBF); const int n8 = DEPTH * M * PLE / 8;
      for (int i = blockIdx.x * (NWAVES * 64) + F.tid; i < n8; i += F.G * NWAVES * 64) { const f32x4 a = p4[2 * i], b = p4[2 * i + 1]; v4u w; w.x = pk2(a.x, a.y); w.y = pk2(a.z, a.w); w.z = pk2(b.x, b.y); w.w = pk2(b.z, b.w); o[i] = w; } }
    for (int m = gw; m < M; m += NGW) rms_row_to_bf16(A.in[I_X] + (size_t)m * DM, (bf16*)(F.ws + WS_XN) + (size_t)m * DM, F.lane);
}

__device__ __forceinline__ void thin_phase(Frame& F, const bf16* Fb, const float* hin, float* hout, const float* gpost, float coef, bf16* xn) {
    const int gw = blockIdx.x * NWAVES + F.wave, NGW = F.G * NWAVES, lane = fresh_lane();
    f32x4 gp[4];
#pragma unroll
    for (int j = 0; j < 4; ++j) gp[j] = *((const GAS f32x4*)gpost + lane + 64 * j);
    for (int m = gw; m < M; m += NGW) {
        const GAS unsigned long long* fr = (const GAS unsigned long long*)(Fb + (size_t)m * DM) + lane;
        const GAS f32x4* hr = (const GAS f32x4*)(hin + (size_t)m * DM) + lane;
        f32x4 f[4], h[4]; float s = 0.f;
#pragma unroll
        for (int j = 0; j < 4; ++j) { const unsigned long long w = fr[64 * j]; h[j] = hr[64 * j];
            f[j].x = __uint_as_float((unsigned)w << 16); f[j].y = __uint_as_float((unsigned)w & 0xffff0000u); f[j].z = __uint_as_float((unsigned)(w >> 32) << 16); f[j].w = __uint_as_float((unsigned)(w >> 32) & 0xffff0000u);
            s += (f[j].x * f[j].x + f[j].y * f[j].y) + (f[j].z * f[j].z + f[j].w * f[j].w); }
        const float r = coef / sqrtf(wave_sum(s) * (1.f / DM) + RMS_EPS); float s2 = 0.f;
#pragma unroll
        for (int j = 0; j < 4; ++j) { h[j] = h[j] + f[j] * gp[j] * r; s2 += (h[j].x * h[j].x + h[j].y * h[j].y) + (h[j].z * h[j].z + h[j].w * h[j].w); }
        GAS f32x4* ho = (GAS f32x4*)(hout + (size_t)m * DM) + lane;
#pragma unroll
        for (int j = 0; j < 4; ++j) ho[64 * j] = h[j];
        if (xn) { const float r2 = 1.0f / sqrtf(wave_sum(s2) * (1.f / DM) + RMS_EPS);
            GAS unsigned long long* o8 = (GAS unsigned long long*)(xn + (size_t)m * DM) + lane;
#pragma unroll
            for (int j = 0; j < 4; ++j) o8[64 * j] = (unsigned long long)pk2(h[j].x * r2, h[j].y * r2) | ((unsigned long long)pk2(h[j].z * r2, h[j].w * r2) << 32); }
    }
}

__device__ __forceinline__ void gmlp_naive_phase(Frame& F, const float* ln_g, const float* ln_b, const float* w_s, const float* b_s) {
    const bf16* GU = (const bf16*)(F.ws + WS_HB) + 3 * ZSTRIDE; const bf16* GV = GU + ZSTRIDE; const bf16* KB = (const bf16*)(F.ws + WS_HB) + ZSTRIDE;
    bf16* MRG = (bf16*)(F.ws + WS_MRG);
    const int g = F.wave, lane = fresh_lane();
    LAS bf16* vn = (LAS bf16*)(F.lds + RING_OFF + g * 16384);
    LAS float* ssqt = (LAS float*)(F.lds + EXTRA_OFF);
    const float lg = ln_g[g * 64 + lane], lb = ln_b[g * 64 + lane];
    const float* w = w_s + (size_t)g * GCH * GCH; const float* bs = b_s + (size_t)g * GCH;
    for (int unit = blockIdx.x; unit < M / GCH; unit += F.G) {
        const size_t R0 = (size_t)unit * GCH;
        for (int s = 0; s < GCH; ++s) { const float v = bf2f(GV[(R0 + s) * 512 + g * 64 + lane]); const float mean = wave_sum(v) * (1.f / 64.f); const float d = v - mean;
            const float var = wave_sum(d * d) * (1.f / 64.f); const float y = d * (1.0f / sqrtf(var + LN_EPS)) * lg + lb; vn[s * 64 + lane] = (bf16)f2bf(y); }
        LDS_WAIT(); asm volatile("" ::: "memory");
        for (int t = 0; t < GCH; ++t) { float a = 0.f;
            for (int s = 0; s <= t; ++s) a += w[t * GCH + s] * bf2f(vn[s * 64 + lane]);
            a += bs[t];
            const float o = bf2f(GU[(R0 + t) * 512 + g * 64 + lane]) * a; const float ss = wave_sum(o * o);
            MRG[(R0 + t) * DM + AW + g * 64 + lane] = (bf16)f2bf(o); if (lane == 0) ssqt[t * 8 + g] = ss; }
        VM_WAIT(); LDS_WAIT(); __syncthreads();
        for (int t = 0; t < GCH; ++t) { float q = 0.f;
#pragma unroll
            for (int k = 0; k < 8; ++k) q += ssqt[t * 8 + k];
            const float r = 1.0f / sqrtf(q * (1.f / GWD) + RMS_EPS); bf16* p = MRG + (R0 + t) * DM + AW + g * 64 + lane; *p = (bf16)f2bf(bf2f(*p) * r); }
        LDS_WAIT(); __syncthreads();
    }
    float* KM = (float*)(F.ws + WS_KM);
    for (int item = blockIdx.x * NWAVES + F.wave; item < BATCH * NH * NBLK; item += F.G * NWAVES) {
        const int b = item >> 6, h = (item >> 3) & 7, n = item & 7; const bf16* kp = KB + ((size_t)b * SEQ + n * MOBA) * 512 + h * 64 + lane; float s = 0.f;
        for (int j = 0; j < MOBA; ++j) s += bf2f(kp[(size_t)j * 512]);
        KM[item * 64 + lane] = s * (1.f / MOBA);
    }
}


typedef float f32x16 __attribute__((ext_vector_type(16)));
__device__ __forceinline__ void gmlp_mfma_phase(Frame& F, const float* ln_g, const float* ln_b, const bf16* WSB, const float* b_s) {
    const bf16* GU = (const bf16*)(F.ws + WS_HB) + 3 * ZSTRIDE; const bf16* GV = GU + ZSTRIDE;
    bf16* MRG = (bf16*)(F.ws + WS_MRG);
    const int g = F.wave, lane = fresh_lane(), r32 = lane & 31, hi = lane >> 5, dch = lane & 7, srow = lane >> 3;
    LAS unsigned char* vt = F.lds + RING_OFF + g * 16384;
    LAS float* ssqt = (LAS float*)(F.lds + EXTRA_OFF);
    float lg[8], lb[8];
#pragma unroll
    for (int k = 0; k < 8; ++k) { lg[k] = ln_g[g * 64 + 8 * dch + k]; lb[k] = ln_b[g * 64 + 8 * dch + k]; }
    for (int unit = blockIdx.x; unit < M / GCH; unit += F.G) {
        const size_t R0 = (size_t)unit * GCH;
#pragma unroll 4
        for (int i = 0; i < 16; ++i) { const int s = i * 8 + srow; const v4u raw = *(const GAS v4u*)(GV + (R0 + s) * 512 + g * 64 + 8 * dch);
            float v[8]; v[0] = __uint_as_float(raw.x << 16); v[1] = __uint_as_float(raw.x & 0xffff0000u); v[2] = __uint_as_float(raw.y << 16); v[3] = __uint_as_float(raw.y & 0xffff0000u);
            v[4] = __uint_as_float(raw.z << 16); v[5] = __uint_as_float(raw.z & 0xffff0000u); v[6] = __uint_as_float(raw.w << 16); v[7] = __uint_as_float(raw.w & 0xffff0000u);
            float sm = ((v[0] + v[1]) + (v[2] + v[3])) + ((v[4] + v[5]) + (v[6] + v[7])); sm = xadd<1>(sm); sm = xadd<2>(sm); sm = xadd<4>(sm);
            const float mean = sm * (1.f / 64.f); float q = 0.f;
#pragma unroll
            for (int k = 0; k < 8; ++k) { v[k] -= mean; q += v[k] * v[k]; }
            q = xadd<1>(q); q = xadd<2>(q); q = xadd<4>(q);
            const float rstd = 1.0f / sqrtf(q * (1.f / 64.f) + LN_EPS);
#pragma unroll
            for (int k = 0; k < 8; ++k) { const int d = 8 * dch + k; const float y = v[k] * rstd * lg[k] + lb[k];
                *(LAS bf16*)(vt + d * 256 + ((i ^ (d & 15)) << 4) + srow * 2) = (bf16)f2bf(y); } }
        LDS_WAIT(); asm volatile("" ::: "memory");
        f32x16 acc[2][4];
#pragma unroll
        for (int dt = 0; dt < 2; ++dt)
#pragma unroll
            for (int tt = 0; tt < 4; ++tt) acc[dt][tt] = f32x16{};
        const bf16* wrow = WSB + ((size_t)g * GCH + r32) * GCH + 8 * hi;
#pragma unroll
        for (int tt = 0; tt < 4; ++tt) { asm volatile("" ::: "memory");
#pragma unroll
            for (int ks = 0; ks < 2 * tt + 2; ++ks) { const bf16x8 bfrag = *(const GAS bf16x8*)(wrow + (size_t)tt * 32 * GCH + ks * 16); const int c = 2 * ks + hi;
#pragma unroll
                for (int dt = 0; dt < 2; ++dt) { const int d = dt * 32 + r32; const bf16x8 afrag = *(const LAS bf16x8*)(vt + d * 256 + ((c ^ (d & 15)) << 4));
                    acc[dt][tt] = __builtin_amdgcn_mfma_f32_32x32x16_bf16(afrag, bfrag, acc[dt][tt], 0, 0, 0); } } }
#pragma unroll
        for (int tt = 0; tt < 4; ++tt) { const int t = tt * 32 + r32; const float bias = b_s[g * GCH + t]; float ss = 0.f;
#pragma unroll
            for (int dt = 0; dt < 2; ++dt)
#pragma unroll
                for (int q4 = 0; q4 < 4; ++q4) { const int d0 = dt * 32 + 8 * q4 + 4 * hi; const unsigned long long gw = *(const GAS unsigned long long*)(GU + (R0 + t) * 512 + g * 64 + d0);
                    const float u0 = __uint_as_float((unsigned)gw << 16), u1 = __uint_as_float((unsigned)gw & 0xffff0000u), u2 = __uint_as_float((unsigned)(gw >> 32) << 16), u3 = __uint_as_float((unsigned)(gw >> 32) & 0xffff0000u);
                    float o0 = u0 * (acc[dt][tt][4 * q4 + 0] + bias), o1 = u1 * (acc[dt][tt][4 * q4 + 1] + bias), o2 = u2 * (acc[dt][tt][4 * q4 + 2] + bias), o3 = u3 * (acc[dt][tt][4 * q4 + 3] + bias);
                    ss += (o0 * o0 + o1 * o1) + (o2 * o2 + o3 * o3); acc[dt][tt][4 * q4 + 0] = o0; acc[dt][tt][4 * q4 + 1] = o1; acc[dt][tt][4 * q4 + 2] = o2; acc[dt][tt][4 * q4 + 3] = o3; }
            ss = xadd<32>(ss); if (hi == 0) ssqt[t * 8 + g] = ss; }
        LDS_WAIT(); __syncthreads();
#pragma unroll
        for (int tt = 0; tt < 4; ++tt) { const int t = tt * 32 + r32; const f32x4 qa = *(const LAS f32x4*)(ssqt + t * 8), qb = *(const LAS f32x4*)(ssqt + t * 8 + 4);
            const float r = 1.0f / sqrtf((((qa.x + qa.y) + (qa.z + qa.w)) + ((qb.x + qb.y) + (qb.z + qb.w))) * (1.f / GWD) + RMS_EPS);
#pragma unroll
            for (int dt = 0; dt < 2; ++dt)
#pragma unroll
                for (int q4 = 0; q4 < 4; ++q4) { const int d0 = dt * 32 + 8 * q4 + 4 * hi;
                    *(GAS unsigned long long*)(MRG + (R0 + t) * DM + AW + g * 64 + d0) = (unsigned long long)pk2(acc[dt][tt][4 * q4 + 0] * r, acc[dt][tt][4 * q4 + 1] * r) | ((unsigned long long)pk2(acc[dt][tt][4 * q4 + 2] * r, acc[dt][tt][4 * q4 + 3] * r) << 32); } }
        LDS_WAIT(); __syncthreads();
    }
    const bf16* KB = (const bf16*)(F.ws + WS_HB) + ZSTRIDE; float* KM = (float*)(F.ws + WS_KM);
    for (int item = blockIdx.x * NWAVES + F.wave; item < BATCH * NH * NBLK; item += F.G * NWAVES) {
        const int b = item >> 6, h = (item >> 3) & 7, n = item & 7; const bf16* kp = KB + ((size_t)b * SEQ + n * MOBA) * 512 + h * 64 + lane; float s = 0.f;
#pragma unroll 16
        for (int j = 0; j < MOBA; ++j) s += bf2f(kp[(size_t)j * 512]);
        KM[item * 64 + lane] = s * (1.f / MOBA);
    }
}

__device__ __forceinline__ void attn_naive_phase(Frame& F) {
    const bf16* Q = (const bf16*)(F.ws + WS_HB); const bf16* KB = Q + ZSTRIDE; const bf16* VB = KB + ZSTRIDE;
    bf16* MRG = (bf16*)(F.ws + WS_MRG); const float* KM = (const float*)(F.ws + WS_KM); float* SSQ = (float*)(F.ws + WS_SSQ);
    const int lane = fresh_lane(); LAS float* qsh = (LAS float*)(F.lds + RING_OFF + F.wave * 256);
    for (int idx = blockIdx.x * NWAVES + F.wave; idx < BATCH * NH * SEQ; idx += F.G * NWAVES) {
        const int bh = idx & 127, t = idx >> 7, b = bh >> 3, h = bh & 7, own = t >> 8; const size_t row = (size_t)b * SEQ + t;
        const float qd = bf2f(Q[row * 512 + h * 64 + lane]);
        const float sl2 = exp2f(-(float)(h + 1)) * LOG2E;
        float gv[NBLK - 1];
#pragma unroll
        for (int n = 0; n < NBLK - 1; ++n) { const float pr = (n < own) ? qd * KM[((size_t)bh * NBLK + n) * 64 + lane] : 0.f; const float sgate = wave_sum(pr); gv[n] = (n < own) ? sgate : -INFINITY; }
        unsigned mask = 0u;
#pragma unroll
        for (int k = 0; k < 3; ++k) { int best = -1; float bv = -INFINITY;
#pragma unroll
            for (int n = 0; n < NBLK - 1; ++n) if (!((mask >> n) & 1u) && gv[n] > bv) { bv = gv[n]; best = n; }
            if (best >= 0) mask |= 1u << best; }
        mask = (unsigned)__builtin_amdgcn_readfirstlane((int)mask);
        qsh[lane] = qd; LDS_WAIT(); asm volatile("" ::: "memory");
        float mrun = -INFINITY, lrun = 0.f, o = 0.f;
        for (int bi = 0; bi <= NBLK - 1; ++bi) {
            int nb; if (bi == 0) nb = own; else { nb = bi - 1; if (!((mask >> nb) & 1u)) continue; }
            for (int tile = 0; tile < 4; ++tile) {
                const int s0 = nb * MOBA + tile * 64; if (s0 > t) break;
                const int s = s0 + lane; const GAS v4u* kr = (const GAS v4u*)(KB + ((size_t)b * SEQ + s) * 512 + h * 64);
                float dot = 0.f;
#pragma unroll
                for (int c = 0; c < 8; ++c) { const v4u kk = kr[c]; float qs[64]; { const f32x4 qa = *(const LAS f32x4*)(qsh + 8 * c), qb = *(const LAS f32x4*)(qsh + 8 * c + 4); qs[8*c]=qa.x; qs[8*c+1]=qa.y; qs[8*c+2]=qa.z; qs[8*c+3]=qa.w; qs[8*c+4]=qb.x; qs[8*c+5]=qb.y; qs[8*c+6]=qb.z; qs[8*c+7]=qb.w; }
                    dot += qs[8 * c + 0] * __uint_as_float(kk.x << 16) + qs[8 * c + 1] * __uint_as_float(kk.x & 0xffff0000u) + qs[8 * c + 2] * __uint_as_float(kk.y << 16) + qs[8 * c + 3] * __uint_as_float(kk.y & 0xffff0000u)
                         + qs[8 * c + 4] * __uint_as_float(kk.z << 16) + qs[8 * c + 5] * __uint_as_float(kk.z & 0xffff0000u) + qs[8 * c + 6] * __uint_as_float(kk.w << 16) + qs[8 * c + 7] * __uint_as_float(kk.w & 0xffff0000u); }
                float x = dot - sl2 * (float)(t - s); if (s > t) x = -INFINITY;
                const float mnew = fmaxf(mrun, wave_max(x)); const float p = exp2f(x - mnew), f = exp2f(mrun - mnew);
                lrun = lrun * f + wave_sum(p); o *= f; mrun = mnew;
                const bf16* vp = VB + ((size_t)b * SEQ + s0) * 512 + h * 64 + lane;
#pragma unroll 8
                for (int j = 0; j < 64; ++j) { const float pj = __uint_as_float((unsigned)__builtin_amdgcn_readlane((int)__float_as_uint(p), j)); o += pj * bf2f(vp[(size_t)j * 512]); }
            }
        }
        const float res = o / lrun; const float ss = wave_sum(res * res);
        MRG[row * DM + h * 64 + lane] = (bf16)f2bf(res); if (lane == 0) SSQ[row * NH + h] = ss;
    }
}
__device__ __forceinline__ void attn_norm_phase(Frame& F) {
    bf16* MRG = (bf16*)(F.ws + WS_MRG); const float* SSQ = (const float*)(F.ws + WS_SSQ); const int lane = fresh_lane();
    for (int m = blockIdx.x * NWAVES + F.wave; m < M; m += F.G * NWAVES) {
        float q = 0.f;
#pragma unroll
        for (int k = 0; k < NH; ++k) q += SSQ[(size_t)m * NH + k];
        const float r = 1.0f / sqrtf(q * (1.f / AW) + RMS_EPS);
        GAS v4u* p = (GAS v4u*)(MRG + (size_t)m * DM) + lane; v4u w = *p;
        w.x = pk2(__uint_as_float(w.x << 16) * r, __uint_as_float(w.x & 0xffff0000u) * r); w.y = pk2(__uint_as_float(w.y << 16) * r, __uint_as_float(w.y & 0xffff0000u) * r);
        w.z = pk2(__uint_as_float(w.z << 16) * r, __uint_as_float(w.z & 0xffff0000u) * r); w.w = pk2(__uint_as_float(w.w << 16) * r, __uint_as_float(w.w & 0xffff0000u) * r);
        *p = w;
    }
}

#ifndef PG8_SP2
#define PG8_SP2 true
#endif
#ifndef PG8_ALIGN
#define PG8_ALIGN true
#endif
__global__ void __launch_bounds__(NWAVES * 64, 2) mk_fwd(Args args) {
    extern __shared__ __attribute__((aligned(16))) unsigned char lds[];
    Frame F;
    F.lds = (LAS unsigned char*)lds; F.MISC = (volatile LAS unsigned*)(F.lds + MISC_OFF);
    F.tid = threadIdx.x; F.lane = F.tid & 63; F.wave = __builtin_amdgcn_readfirstlane(F.tid >> 6); F.G = gridDim.x;
    F.ws = args.ws; F.out = args.out; F.ctl = (gu32*)(args.ws + WS_CTL);
    for (int u = F.tid; u < (LDS_BYTES - LDSCTL_OFF) / 4; u += NWAVES * 64) ((LAS unsigned*)(F.lds + LDSCTL_OFF))[u] = 0u;
    __syncthreads();
    XcdBarrier bar = xcd_barrier_post((unsigned*)(F.ctl + CW_BAR), F.MISC + 8, F.tid == 0);
#define GRID_BAR() xcd_barrier(bar, F.wave == 0 && hw_lane() == 0)
    using pg8::bf16_t;
    bf16_t* XN = (bf16_t*)(F.ws + WS_XN); bf16_t* HB = (bf16_t*)(F.ws + WS_HB); bf16_t* MRG = (bf16_t*)(F.ws + WS_MRG); bf16_t* FB = (bf16_t*)(F.ws + WS_FB);

    p0_prologue(F, args); GRID_BAR();

        { constexpr int l = 0;

    {
        const bf16_t* wl = (const bf16_t*)(F.ws + WS_W + (size_t)l * WL_STRIDE);
        { pg8::Gemm g{XN, wl + WL_GU1 / 2, M, 2 * DFF, DM}; pg8::StaticOrder S; S.init(M, 2 * DFF, F.G, (int)blockIdx.x); pg8::EpiSwiGLU E{HB, DFF};
          pg8::gemm_phase<pg8::EpiSwiGLU, pg8::StaticOrder, PG8_ALIGN, PG8_SP2>(F.lds + RING_OFF, g, S, E, F.wave); }
        GRID_BAR();
        { pg8::Gemm g{HB, wl + WL_D1 / 2, M, DM, DFF}; pg8::StaticOrder S; S.init(M, DM, F.G, (int)blockIdx.x); pg8::EpiBf16<0> E{FB, DM, nullptr, 0, 0, 1.f};
          pg8::gemm_phase<pg8::EpiBf16<0>, pg8::StaticOrder, PG8_ALIGN, PG8_SP2>(F.lds + RING_OFF, g, S, E, F.wave); }
        GRID_BAR();
        thin_phase(F, (const bf16*)FB, l == 0 ? args.in[I_X] : F.out, F.out, args.in[I_F1POST] + l * DM, 0.5f, (bf16*)XN);
        GRID_BAR();
        { pg8::Gemm g{XN, wl + WL_IN / 2, M, INW, DM}; pg8::StaticOrder S; S.init(M, INW, F.G, (int)blockIdx.x); pg8::EpiInProj E{HB, ZSTRIDE, QSCALE};
          pg8::gemm_phase<pg8::EpiInProj, pg8::StaticOrder, PG8_ALIGN, PG8_SP2>(F.lds + RING_OFF, g, S, E, F.wave); }
        GRID_BAR();
        gmlp_mfma_phase(F, args.in[I_LNG] + l * GWD, args.in[I_LNB] + l * GWD, (const bf16*)(F.ws + WS_WSB) + (size_t)l * NGRP * GCH * GCH, args.in[I_BS] + (size_t)l * NGRP * GCH);
        GRID_BAR();
        { const attn_body::AttnTensors AT{(const attn_body::bf16*)(F.ws + WS_HB), (const attn_body::bf16*)(F.ws + WS_HB) + ZSTRIDE, (const attn_body::bf16*)(F.ws + WS_HB) + 2 * ZSTRIDE, (attn_body::bf16*)(F.ws + WS_MRG), (float*)(F.ws + WS_SSQ), (const float*)(F.ws + WS_KM)};
          const attn_body::MobaOrder S((int)F.G, (int)blockIdx.x); attn_body::attn_phase<attn_body::MobaOrder>((char*)lds + RING_OFF, AT, S, F.wave); }
        GRID_BAR();
        attn_norm_phase(F);
        GRID_BAR();
        { pg8::Gemm g{MRG, wl + WL_OUT / 2, M, DM, DM}; pg8::StaticOrder S; S.init(M, DM, F.G, (int)blockIdx.x); pg8::EpiBf16<0> E{FB, DM, nullptr, 0, 0, 1.f};
          pg8::gemm_phase<pg8::EpiBf16<0>, pg8::StaticOrder, PG8_ALIGN, PG8_SP2>(F.lds + RING_OFF, g, S, E, F.wave); }
        GRID_BAR();
        thin_phase(F, (const bf16*)FB, F.out, F.out, args.in[I_MIXPOST] + l * DM, 1.0f, (bf16*)XN);
        GRID_BAR();
        { pg8::Gemm g{XN, wl + WL_GU2 / 2, M, 2 * DFF, DM}; pg8::StaticOrder S; S.init(M, 2 * DFF, F.G, (int)blockIdx.x); pg8::EpiSwiGLU E{HB, DFF};
          pg8::gemm_phase<pg8::EpiSwiGLU, pg8::StaticOrder, PG8_ALIGN, PG8_SP2>(F.lds + RING_OFF, g, S, E, F.wave); }
        GRID_BAR();
        { pg8::Gemm g{HB, wl + WL_D2 / 2, M, DM, DFF}; pg8::StaticOrder S; S.init(M, DM, F.G, (int)blockIdx.x); pg8::EpiBf16<0> E{FB, DM, nullptr, 0, 0, 1.f};
          pg8::gemm_phase<pg8::EpiBf16<0>, pg8::StaticOrder, PG8_ALIGN, PG8_SP2>(F.lds + RING_OFF, g, S, E, F.wave); }
        GRID_BAR();
        { pg8::Gemm g{(const bf16_t*)(F.ws + WS_PBF) + (size_t)l * M * PLE, wl + WL_PP / 2, M, DM, PLE}; pg8::StaticOrder S; S.init(M, DM, F.G, (int)blockIdx.x); pg8::EpiBf16<0> E{HB, DM, nullptr, 0, 0, 1.f};
          pg8::gemm_phase<pg8::EpiBf16<0>, pg8::StaticOrder, PG8_ALIGN, PG8_SP2>(F.lds + RING_OFF, g, S, E, F.wave); }
        thin_phase(F, (const bf16*)FB, F.out, F.out, args.in[I_F2POST] + l * DM, 0.5f, (bf16*)XN);
        GRID_BAR();
        { pg8::Gemm g{XN, wl + WL_PG / 2, M, DM, DM}; pg8::StaticOrder S; S.init(M, DM, F.G, (int)blockIdx.x); pg8::EpiPleGate E{FB, HB, DM};
          pg8::gemm_phase<pg8::EpiPleGate, pg8::StaticOrder, PG8_ALIGN, PG8_SP2>(F.lds + RING_OFF, g, S, E, F.wave); }
        GRID_BAR();
        thin_phase(F, (const bf16*)FB, F.out, F.out, args.in[I_PLEPOST] + l * DM, 1.0f, l + 1 < DEPTH ? (bf16*)XN : (bf16*)nullptr);
        if (l + 1 < DEPTH) GRID_BAR();
    }
        }
    { constexpr int l = 1;

    {
        const bf16_t* wl = (const bf16_t*)(F.ws + WS_W + (size_t)l * WL_STRIDE);
        { pg8::Gemm g{XN, wl + WL_GU1 / 2, M, 2 * DFF, DM}; pg8::StaticOrder S; S.init(M, 2 * DFF, F.G, (int)blockIdx.x); pg8::EpiSwiGLU E{HB, DFF};
          pg8::gemm_phase<pg8::EpiSwiGLU, pg8::StaticOrder, PG8_ALIGN, PG8_SP2>(F.lds + RING_OFF, g, S, E, F.wave); }
        GRID_BAR();
        { pg8::Gemm g{HB, wl + WL_D1 / 2, M, DM, DFF}; pg8::StaticOrder S; S.init(M, DM, F.G, (int)blockIdx.x); pg8::EpiBf16<0> E{FB, DM, nullptr, 0, 0, 1.f};
          pg8::gemm_phase<pg8::EpiBf16<0>, pg8::StaticOrder, PG8_ALIGN, PG8_SP2>(F.lds + RING_OFF, g, S, E, F.wave); }
        GRID_BAR();
        thin_phase(F, (const bf16*)FB, l == 0 ? args.in[I_X] : F.out, F.out, args.in[I_F1POST] + l * DM, 0.5f, (bf16*)XN);
        GRID_BAR();
        { pg8::Gemm g{XN, wl + WL_IN / 2, M, INW, DM}; pg8::StaticOrder S; S.init(M, INW, F.G, (int)blockIdx.x); pg8::EpiInProj E{HB, ZSTRIDE, QSCALE};
          pg8::gemm_phase<pg8::EpiInProj, pg8::StaticOrder, PG8_ALIGN, PG8_SP2>(F.lds + RING_OFF, g, S, E, F.wave); }
        GRID_BAR();
        gmlp_mfma_phase(F, args.in[I_LNG] + l * GWD, args.in[I_LNB] + l * GWD, (const bf16*)(F.ws + WS_WSB) + (size_t)l * NGRP * GCH * GCH, args.in[I_BS] + (size_t)l * NGRP * GCH);
        GRID_BAR();
        { const attn_body::AttnTensors AT{(const attn_body::bf16*)(F.ws + WS_HB), (const attn_body::bf16*)(F.ws + WS_HB) + ZSTRIDE, (const attn_body::bf16*)(F.ws + WS_HB) + 2 * ZSTRIDE, (attn_body::bf16*)(F.ws + WS_MRG), (float*)(F.ws + WS_SSQ), (const float*)(F.ws + WS_KM)};
          const attn_body::MobaOrder S((int)F.G, (int)blockIdx.x); attn_body::attn_phase<attn_body::MobaOrder>((char*)lds + RING_OFF, AT, S, F.wave); }
        GRID_BAR();
        attn_norm_phase(F);
        GRID_BAR();
        { pg8::Gemm g{MRG, wl + WL_OUT / 2, M, DM, DM}; pg8::StaticOrder S; S.init(M, DM, F.G, (int)blockIdx.x); pg8::EpiBf16<0> E{FB, DM, nullptr, 0, 0, 1.f};
          pg8::gemm_phase<pg8::EpiBf16<0>, pg8::StaticOrder, PG8_ALIGN, PG8_SP2>(F.lds + RING_OFF, g, S, E, F.wave); }
        GRID_BAR();
        thin_phase(F, (const bf16*)FB, F.out, F.out, args.in[I_MIXPOST] + l * DM, 1.0f, (bf16*)XN);
        GRID_BAR();
        { pg8::Gemm g{XN, wl + WL_GU2 / 2, M, 2 * DFF, DM}; pg8::StaticOrder S; S.init(M, 2 * DFF, F.G, (int)blockIdx.x); pg8::EpiSwiGLU E{HB, DFF};
          pg8::gemm_phase<pg8::EpiSwiGLU, pg8::StaticOrder, PG8_ALIGN, PG8_SP2>(F.lds + RING_OFF, g, S, E, F.wave); }
        GRID_BAR();
        { pg8::Gemm g{HB, wl + WL_D2 / 2, M, DM, DFF}; pg8::StaticOrder S; S.init(M, DM, F.G, (int)blockIdx.x); pg8::EpiBf16<0> E{FB, DM, nullptr, 0, 0, 1.f};
          pg8::gemm_phase<pg8::EpiBf16<0>, pg8::StaticOrder, PG8_ALIGN, PG8_SP2>(F.lds + RING_OFF, g, S, E, F.wave); }
        GRID_BAR();
        { pg8::Gemm g{(const bf16_t*)(F.ws + WS_PBF) + (size_t)l * M * PLE, wl + WL_PP / 2, M, DM, PLE}; pg8::StaticOrder S; S.init(M, DM, F.G, (int)blockIdx.x); pg8::EpiBf16<0> E{HB, DM, nullptr, 0, 0, 1.f};
          pg8::gemm_phase<pg8::EpiBf16<0>, pg8::StaticOrder, PG8_ALIGN, PG8_SP2>(F.lds + RING_OFF, g, S, E, F.wave); }
        thin_phase(F, (const bf16*)FB, F.out, F.out, args.in[I_F2POST] + l * DM, 0.5f, (bf16*)XN);
        GRID_BAR();
        { pg8::Gemm g{XN, wl + WL_PG / 2, M, DM, DM}; pg8::StaticOrder S; S.init(M, DM, F.G, (int)blockIdx.x); pg8::EpiPleGate E{FB, HB, DM};
          pg8::gemm_phase<pg8::EpiPleGate, pg8::StaticOrder, PG8_ALIGN, PG8_SP2>(F.lds + RING_OFF, g, S, E, F.wave); }
        GRID_BAR();
        thin_phase(F, (const bf16*)FB, F.out, F.out, args.in[I_PLEPOST] + l * DM, 1.0f, l + 1 < DEPTH ? (bf16*)XN : (bf16*)nullptr);
        if (l + 1 < DEPTH) GRID_BAR();
    }
        }

}

extern "C" void kernel_launch(void* const* d_in, const int* in_sizes, int n_in, void* d_out, int out_size, void* d_ws, size_t ws_size, hipStream_t stream) {
    static int grid = 0;
    if (grid == 0) {
        if (n_in != 26 || in_sizes[0] != M * DM || out_size != M * DM || ws_size < WS_END) { fprintf(stderr, "kernel_launch: unexpected shapes (n_in %d, in0 %d, out %d, ws %zu)\n", n_in, n_in > 0 ? in_sizes[0] : -1, out_size, ws_size); grid = -1; return; }
        int dev = 0, cus = 0, per_cu = 0;
        if (hipGetDevice(&dev) != hipSuccess || hipDeviceGetAttribute(&cus, hipDeviceAttributeMultiprocessorCount, dev) != hipSuccess) { grid = -1; return; }
        if (hipFuncSetAttribute((const void*)mk_fwd, hipFuncAttributeMaxDynamicSharedMemorySize, LDS_BYTES) != hipSuccess) { fprintf(stderr, "kernel_launch: hipFuncSetAttribute failed\n"); grid = -1; return; }
        if (hipOccupancyMaxActiveBlocksPerMultiprocessor(&per_cu, (const void*)mk_fwd, NWAVES * 64, LDS_BYTES) != hipSuccess || per_cu < 1) { fprintf(stderr, "kernel_launch: occupancy query reports %d\n", per_cu); }
        (void)hipGetLastError();
        grid = cus;
    }
    if (grid < 0) return;
    if (hipMemsetAsync((char*)d_ws + WS_CTL, 0, CTL_ZERO_BYTES, stream) != hipSuccess) return;
    Args a{};
    for (int i = 0; i < 26; ++i) a.in[i] = (const float*)d_in[i];
    a.out = (float*)d_out; a.ws = (unsigned char*)d_ws;
    hipLaunchKernelGGL(mk_fwd, dim3(grid), dim3(NWAVES * 64), LDS_BYTES, stream, a);
}
```

```cpp
#include <hip/hip_runtime.h>
#include <cstdio>
#include <cstdint>
#include <cmath>
namespace pg8 {
#define PG8_LAS __attribute__((address_space(3)))
typedef unsigned short bf16_t;
typedef short bf16x8 __attribute__((ext_vector_type(8)));
typedef float f32x4 __attribute__((ext_vector_type(4)));
typedef unsigned u32x4 __attribute__((ext_vector_type(4)));
constexpr int BM = 256, BK = 64, HALF = 128, HTB = HALF * BK * 2  , STAGE_BYTES = 8 * HTB, NXCD = 8, WGM = 8;

__host__ __device__ __forceinline__ int lds_byte(int r, int c) { const int st = (r >> 4) * 2 + (c >> 5), rr = r & 15, cc = c & 31, ob = rr * 64 + cc * 2; return st * 1024 + (ob ^ (((ob >> 9) & 1) << 5)); }
__host__ __device__ __forceinline__ void stage_rc(int b, int& R, int& C) { const int st = b / 1024, sb = b % 1024, swz = sb ^ (((sb >> 9) & 1) << 5); R = (st >> 1) * 16 + swz / 64; C = (st & 1) * 32 + (swz % 64) / 2; }
__host__ __device__ __forceinline__ int perm32(int rho) { const int n = rho >> 4, i = rho & 15; return 8 * (i >> 2) + 4 * n + (i & 3); }

struct Unit { int pm, pn; };
struct Gemm { const bf16_t* A; const bf16_t* Bt; int M, N, K; };

struct StaticOrder {
    int nM, nN, nwg, G, c;
    __host__ __device__ void init(int M, int N, int G_, int c_) { nM = M / BM; nN = N / BM; nwg = nM * nN; G = G_; c = c_; }
    __host__ __device__ bool next(int i, Unit& u) const {
        const long L = (long)i * G + c; if (L >= nwg) return false;
        int wgid = (int)L; { const int q = nwg / NXCD, r = nwg % NXCD, xcd = wgid % NXCD, off = wgid / NXCD; wgid = (xcd < r ? xcd * (q + 1) : r * (q + 1) + (xcd - r) * q) + off; }
        const int nig = WGM * nN, gid = wgid / nig, fm = gid * WGM, gsz = (nM - fm) < WGM ? (nM - fm) : WGM;
        u.pm = fm + ((wgid % nig) % gsz); u.pn = (wgid % nig) / gsz; return true;
    }
    __device__ __forceinline__ void a_ready(const Unit&) const {}
    __device__ __forceinline__ void done(const Unit&) const {}
};

__device__ __forceinline__ unsigned cvt_pk_bf16(float lo, float hi) { unsigned r; asm volatile("v_cvt_pk_bf16_f32 %0, %1, %2" : "=v"(r) : "v"(lo), "v"(hi)); return r; }
typedef float f32x2 __attribute__((ext_vector_type(2)));
__device__ __forceinline__ f32x2 gelu_pk(f32x2 v) {
    const f32x2 av = __builtin_elementwise_abs(v), d = av * 0.2316418882f + 1.0f;
    f32x2 t; t.x = __builtin_amdgcn_rcpf(d.x); t.y = __builtin_amdgcn_rcpf(d.y);
    f32x2 q = t * 0.5307027145f + (-0.7265760135f); q = q * t + 0.7107068705f; q = q * t + (-0.142248368f); q = q * t + 0.127414796f; q = q * t;
    const f32x2 s = (v * v) * (-0.72134752044f);
    f32x2 e; e.x = __builtin_amdgcn_exp2f(s.x); e.y = __builtin_amdgcn_exp2f(s.y);
    const f32x2 m = v * (q * e), r = v - m;
    f32x2 o; o.x = v.x < 0.f ? m.x : r.x; o.y = v.y < 0.f ? m.y : r.y; return o;
}

template <int ACT  > struct EpiBf16 {
    static constexpr bool PERM = true, AFTER_DRAIN = false; static_assert(ACT == 0 || ACT == 1, "EpiBf16: ACT is 0 (none) or 1 (gelu_pk)");
    bf16_t* O; int ldc; const float* bias; int split_cols; size_t split_stride; float scale0;
    __device__ __forceinline__ void operator()(const f32x4 (&acc)[2][2][4][2], const Unit& u, int wr, int wc, int fr, int fq) const {
        const int row0 = u.pm * BM + wr * 64 + fr; int colt = u.pn * BM; bf16_t* base = O;
        float sc = 1.f; if (split_cols) { const int t = colt / split_cols; base += (size_t)t * split_stride; colt -= t * split_cols; if (t == 0) sc = scale0; }
        const int col0 = colt + wc * 32 + 8 * fq, bcol0 = u.pn * BM + wc * 32 + 8 * fq;
        f32x4 bv[2][2];
#pragma unroll
        for (int bj = 0; bj < 2; ++bj)
#pragma unroll
            for (int n = 0; n < 2; ++n) bv[bj][n] = bias ? *(const f32x4*)(bias + bcol0 + bj * HALF + 4 * n) : (f32x4){0.f, 0.f, 0.f, 0.f};
#pragma unroll
        for (int ai = 0; ai < 2; ++ai)
#pragma unroll
            for (int m = 0; m < 4; ++m) { bf16_t* rowp = base + (size_t)(row0 + ai * HALF + m * 16) * ldc + col0;
#pragma unroll
                for (int bj = 0; bj < 2; ++bj) { f32x4 v0 = acc[ai][bj][m][0] + bv[bj][0], v1 = acc[ai][bj][m][1] + bv[bj][1];
                    if (ACT == 1) { f32x2 a = gelu_pk((f32x2){v0[0], v0[1]}), b = gelu_pk((f32x2){v0[2], v0[3]}), c = gelu_pk((f32x2){v1[0], v1[1]}), d = gelu_pk((f32x2){v1[2], v1[3]});
                        v0 = (f32x4){a.x, a.y, b.x, b.y}; v1 = (f32x4){c.x, c.y, d.x, d.y}; }
                    v0 = v0 * sc; v1 = v1 * sc; u32x4 w; w.x = cvt_pk_bf16(v0[0], v0[1]); w.y = cvt_pk_bf16(v0[2], v0[3]); w.z = cvt_pk_bf16(v1[0], v1[1]); w.w = cvt_pk_bf16(v1[2], v1[3]);
                    *(u32x4*)(rowp + bj * HALF) = w; } }
    }
};
__device__ __forceinline__ float fast_sigmoid(float x) { return __builtin_amdgcn_rcpf(1.0f + __builtin_amdgcn_exp2f(x * -1.4426950408889634f)); }
struct EpiSwiGLU {
    static constexpr bool PERM = true, AFTER_DRAIN = false;
    bf16_t* O; int ldc; const float* rs;
    __device__ __forceinline__ void operator()(const f32x4 (&acc)[2][2][4][2], const Unit& u, int wr, int wc, int fr, int fq) const {
        const int row0 = u.pm * BM + wr * 64 + fr, col0 = u.pn * HALF + wc * 32 + 8 * fq;
#pragma unroll
        for (int ai = 0; ai < 2; ++ai)
#pragma unroll
            for (int m = 0; m < 4; ++m) { bf16_t* rowp = O + (size_t)(row0 + ai * HALF + m * 16) * ldc + col0; const float rr = rs[row0 + ai * HALF + m * 16];
                float o[8];
#pragma unroll
                for (int n = 0; n < 2; ++n)
#pragma unroll
                    for (int i = 0; i < 4; ++i) { const float g = acc[ai][0][m][n][i] * rr, up = acc[ai][1][m][n][i] * rr; o[n * 4 + i] = g * fast_sigmoid(g) * up; }
                u32x4 w; w.x = cvt_pk_bf16(o[0], o[1]); w.y = cvt_pk_bf16(o[2], o[3]); w.z = cvt_pk_bf16(o[4], o[5]); w.w = cvt_pk_bf16(o[6], o[7]);
                *(u32x4*)rowp = w; }
    }
};
struct EpiInProj {
    static constexpr bool PERM = true, AFTER_DRAIN = false;
    bf16_t* Z; size_t zstride; float qscale; const float* rs;
    __device__ __forceinline__ void operator()(const f32x4 (&acc)[2][2][4][2], const Unit& u, int wr, int wc, int fr, int fq) const {
        const int t = u.pn >> 1; const int row0 = u.pm * BM + wr * 64 + fr, col0 = (u.pn & 1) * BM + wc * 32 + 8 * fq;
        bf16_t* base = Z + (size_t)t * zstride; const float sc = (t == 0) ? qscale : 1.0f; const bool act = (t >= 3);
#pragma unroll
        for (int ai = 0; ai < 2; ++ai)
#pragma unroll
            for (int m = 0; m < 4; ++m) { bf16_t* rowp = base + (size_t)(row0 + ai * HALF + m * 16) * 512 + col0; const float rr = rs[row0 + ai * HALF + m * 16];
#pragma unroll
                for (int bj = 0; bj < 2; ++bj) { f32x4 v0 = acc[ai][bj][m][0] * rr, v1 = acc[ai][bj][m][1] * rr;
                    if (act) { f32x2 a = gelu_pk((f32x2){v0[0], v0[1]}), b = gelu_pk((f32x2){v0[2], v0[3]}), c = gelu_pk((f32x2){v1[0], v1[1]}), d = gelu_pk((f32x2){v1[2], v1[3]});
                        v0 = (f32x4){a.x, a.y, b.x, b.y}; v1 = (f32x4){c.x, c.y, d.x, d.y}; }
                    v0 = v0 * sc; v1 = v1 * sc; u32x4 w; w.x = cvt_pk_bf16(v0[0], v0[1]); w.y = cvt_pk_bf16(v0[2], v0[3]); w.z = cvt_pk_bf16(v1[0], v1[1]); w.w = cvt_pk_bf16(v1[2], v1[3]);
                    *(u32x4*)(rowp + bj * HALF) = w; } }
    }
};
struct EpiPleGate {
    static constexpr bool PERM = true, AFTER_DRAIN = false;
    bf16_t* O; const bf16_t* E0; int ldc; const float* rs;
    __device__ __forceinline__ void operator()(const f32x4 (&acc)[2][2][4][2], const Unit& u, int wr, int wc, int fr, int fq) const {
        const int row0 = u.pm * BM + wr * 64 + fr, col0 = u.pn * BM + wc * 32 + 8 * fq;
#pragma unroll
        for (int ai = 0; ai < 2; ++ai)
#pragma unroll
            for (int m = 0; m < 4; ++m) { const size_t off = (size_t)(row0 + ai * HALF + m * 16) * ldc + col0; const float rr = rs[row0 + ai * HALF + m * 16];
#pragma unroll
                for (int bj = 0; bj < 2; ++bj) { const u32x4 e = *(const u32x4*)(E0 + off + bj * HALF); const f32x4 v0 = acc[ai][bj][m][0] * rr, v1 = acc[ai][bj][m][1] * rr;
                    float o[8];
                    o[0] = fast_sigmoid(v0[0]) * __uint_as_float(e.x << 16); o[1] = fast_sigmoid(v0[1]) * __uint_as_float(e.x & 0xffff0000u);
                    o[2] = fast_sigmoid(v0[2]) * __uint_as_float(e.y << 16); o[3] = fast_sigmoid(v0[3]) * __uint_as_float(e.y & 0xffff0000u);
                    o[4] = fast_sigmoid(v1[0]) * __uint_as_float(e.z << 16); o[5] = fast_sigmoid(v1[1]) * __uint_as_float(e.z & 0xffff0000u);
                    o[6] = fast_sigmoid(v1[2]) * __uint_as_float(e.w << 16); o[7] = fast_sigmoid(v1[3]) * __uint_as_float(e.w & 0xffff0000u);
                    u32x4 w; w.x = cvt_pk_bf16(o[0], o[1]); w.y = cvt_pk_bf16(o[2], o[3]); w.z = cvt_pk_bf16(o[4], o[5]); w.w = cvt_pk_bf16(o[6], o[7]);
                    *(u32x4*)(O + off + bj * HALF) = w; } }
    }
};
template <class Epi, class Sched, bool ALIGN_EPI = false, bool SP2 = false>
__device__ __forceinline__ void gemm_phase(PG8_LAS unsigned char* lds, const Gemm g, const Sched& S, const Epi& E, const int wv  ) {
    int tid_ = wv * 64 + (int)__builtin_amdgcn_mbcnt_hi(~0u, __builtin_amdgcn_mbcnt_lo(~0u, 0u)); asm volatile("" : "+v"(tid_));
    const int tid = tid_, wid = __builtin_amdgcn_readfirstlane(tid >> 6), lane = tid & 63, wr = wid >> 2, wc = wid & 3, fr = lane & 15, fq = lane >> 4;
    const int K = g.K, nt = K / BK;
    unsigned voffA[2], voffB[2];
#pragma unroll
    for (int i = 0; i < 2; ++i) { int R, C; stage_rc(tid * 16 + i * 8192, R, C); const int Rb = Epi::PERM ? ((R & ~31) + perm32(R & 31)) : R;
        voffA[i] = (unsigned)(R * K + C) * 2u; voffB[i] = (unsigned)(Rb * K + C) * 2u; }
    const size_t kstep = (size_t)(BK * 2);
    const size_t hstep = (size_t)HALF * K * 2;
    const size_t tstep = 2 * hstep;
    const unsigned ldsw = (unsigned)wid * 1024u;
    const int aoff = lds_byte(wr * 64 + fr, fq * 8), boff = lds_byte(wc * 32 + fr, fq * 8);
#define PG8_SA(b, h) (((b) * 2 + (h)) * HTB)
#define PG8_SB(b, h) ((4 + (b) * 2 + (h)) * HTB)
#define PG8_STAGE(bufoff, gbase, voff) do { _Pragma("unroll") for (int _i = 0; _i < 2; ++_i) \
        __builtin_amdgcn_global_load_lds((const unsigned*)((const char*)(gbase) + (voff)[_i]), (PG8_LAS unsigned*)(lds + (bufoff) + ldsw + _i * 8192), 16, 0, 0); } while (0)
#define PG8_LDA(dst, b, h) do { _Pragma("unroll") for (int m = 0; m < 4; ++m) _Pragma("unroll") for (int k = 0; k < 2; ++k) dst[m][k] = *(const PG8_LAS bf16x8*)(lds + PG8_SA(b, h) + aoff + m * 2048 + k * 1024); } while (0)
#define PG8_LDB(dst, b, h) do { _Pragma("unroll") for (int n = 0; n < 2; ++n) _Pragma("unroll") for (int k = 0; k < 2; ++k) dst[n][k] = *(const PG8_LAS bf16x8*)(lds + PG8_SB(b, h) + boff + n * 2048 + k * 1024); } while (0)
#define PG8_MMA(ai, bj, At, Bt) do { __builtin_amdgcn_s_setprio(1); _Pragma("unroll") for (int m = 0; m < 4; ++m) _Pragma("unroll") for (int n = 0; n < 2; ++n) _Pragma("unroll") for (int k = 0; k < 2; ++k) \
        acc[ai][bj][m][n] = __builtin_amdgcn_mfma_f32_16x16x32_bf16(Bt[n][k], At[m][k], acc[ai][bj][m][n], 0, 0, 0); __builtin_amdgcn_s_setprio(0); } while (0)
#define PG8_WAIT_V(n) asm volatile("s_waitcnt vmcnt(" #n ")" ::: "memory")
#define PG8_WAIT_L(n) asm volatile("s_waitcnt lgkmcnt(" #n ")" ::: "memory")
#define PG8_BAR __builtin_amdgcn_s_barrier()
#define PG8_SCHED __builtin_amdgcn_sched_barrier(0)
    Unit cur, nxt; int ui = 0;
    if (!S.next(0, cur)) return;
    f32x4 acc[2][2][4][2];
#pragma unroll
    for (int a = 0; a < 2; ++a)
#pragma unroll
        for (int b = 0; b < 2; ++b)
#pragma unroll
            for (int m = 0; m < 4; ++m)
#pragma unroll
                for (int n = 0; n < 2; ++n) acc[a][b][m][n] = (f32x4){0.f, 0.f, 0.f, 0.f};
    bf16x8 At[4][2], B0[2][2], B1[2][2];
    const char* cA = (const char*)g.A + (size_t)cur.pm * tstep; const char* cB = (const char*)g.Bt + (size_t)cur.pn * tstep;
    S.a_ready(cur);
    if constexpr (SP2) {
        PG8_STAGE(PG8_SB(0, 0), cB, voffB); PG8_STAGE(PG8_SB(0, 1), cB + hstep, voffB); PG8_STAGE(PG8_SA(0, 0), cA, voffA); PG8_STAGE(PG8_SA(0, 1), cA + hstep, voffA);
        if (wr == 1) PG8_BAR;
        PG8_WAIT_V(2); PG8_BAR;
        PG8_STAGE(PG8_SB(1, 0), cB + kstep, voffB); PG8_STAGE(PG8_SA(1, 0), cA + kstep, voffA); PG8_STAGE(PG8_SB(1, 1), cB + hstep + kstep, voffB);
        PG8_WAIT_V(6); PG8_BAR;
    } else {
        PG8_STAGE(PG8_SB(0, 0), cB, voffB); PG8_STAGE(PG8_SA(0, 0), cA, voffA); PG8_STAGE(PG8_SB(0, 1), cB + hstep, voffB); PG8_STAGE(PG8_SA(0, 1), cA + hstep, voffA);
        if (wr == 1) PG8_BAR;
        PG8_WAIT_V(4); PG8_BAR;
        PG8_STAGE(PG8_SB(1, 0), cB + kstep, voffB); PG8_STAGE(PG8_SA(1, 0), cA + kstep, voffA); PG8_STAGE(PG8_SB(1, 1), cB + hstep + kstep, voffB);
        PG8_WAIT_V(6); PG8_BAR;
    }
    for (;;) {
        const bool has_next = S.next(ui + 1, nxt);
        const char* nA = has_next ? (const char*)g.A + (size_t)nxt.pm * tstep : cA; const char* nB = has_next ? (const char*)g.Bt + (size_t)nxt.pn * tstep : cB;
        for (int t = 0; t < nt; t += 2) {
            const bool last = (t == nt - 2);
            const char* a1 = cA + (size_t)(t + 1) * kstep;
            const char* a2 = last ? nA : cA + (size_t)(t + 2) * kstep; const char* b2 = last ? nB : cB + (size_t)(t + 2) * kstep;
            const char* a3 = a2 + kstep; const char* b3 = b2 + kstep;
            if (last && has_next) S.a_ready(nxt);
            if constexpr (SP2) {
            PG8_LDB(B0, 0, 0); PG8_LDB(B1, 0, 1); PG8_SCHED; PG8_LDA(At, 0, 0); PG8_STAGE(PG8_SA(1, 1), a1 + hstep, voffA);
            PG8_WAIT_V(8); PG8_WAIT_L(0); PG8_BAR; PG8_MMA(0, 0, At, B0); PG8_MMA(0, 1, At, B1); PG8_BAR; PG8_SCHED;
            PG8_LDA(At, 0, 1); PG8_STAGE(PG8_SB(0, 0), b2, voffB); PG8_STAGE(PG8_SB(0, 1), b2 + hstep, voffB); PG8_STAGE(PG8_SA(0, 0), a2, voffA);
            PG8_WAIT_V(8); PG8_WAIT_L(0); PG8_BAR; PG8_MMA(1, 0, At, B0); PG8_MMA(1, 1, At, B1); PG8_BAR; PG8_SCHED;
            PG8_LDB(B0, 1, 0); PG8_LDB(B1, 1, 1); PG8_SCHED; PG8_LDA(At, 1, 0); PG8_STAGE(PG8_SA(0, 1), a2 + hstep, voffA);
            PG8_WAIT_V(8); PG8_WAIT_L(0); PG8_BAR; PG8_MMA(0, 0, At, B0); PG8_MMA(0, 1, At, B1); PG8_BAR; PG8_SCHED;
            PG8_LDA(At, 1, 1); PG8_STAGE(PG8_SB(1, 0), b3, voffB); PG8_STAGE(PG8_SB(1, 1), b3 + hstep, voffB); PG8_STAGE(PG8_SA(1, 0), a3, voffA);
            PG8_WAIT_V(8); PG8_WAIT_L(0); PG8_BAR; PG8_MMA(1, 0, At, B0); PG8_MMA(1, 1, At, B1); PG8_BAR; PG8_SCHED;
            } else {
            PG8_LDB(B0, 0, 0); PG8_SCHED; PG8_LDA(At, 0, 0); PG8_STAGE(PG8_SA(1, 1), a1 + hstep, voffA);
            PG8_WAIT_L(8); PG8_BAR; PG8_WAIT_L(0); PG8_MMA(0, 0, At, B0); PG8_BAR; PG8_SCHED;
            PG8_LDB(B1, 0, 1); PG8_STAGE(PG8_SB(0, 0), b2, voffB);
            PG8_BAR; PG8_WAIT_L(0); PG8_MMA(0, 1, At, B1); PG8_BAR;
            PG8_LDA(At, 0, 1); PG8_STAGE(PG8_SA(0, 0), a2, voffA);
            PG8_BAR; PG8_WAIT_L(0); PG8_MMA(1, 0, At, B0); PG8_BAR; PG8_SCHED;
            PG8_STAGE(PG8_SB(0, 1), b2 + hstep, voffB);
            PG8_WAIT_V(6); PG8_BAR; PG8_MMA(1, 1, At, B1); PG8_BAR;
            PG8_LDB(B0, 1, 0); PG8_SCHED; PG8_LDA(At, 1, 0); PG8_STAGE(PG8_SA(0, 1), a2 + hstep, voffA);
            PG8_WAIT_L(8); PG8_BAR; PG8_WAIT_L(0); PG8_MMA(0, 0, At, B0); PG8_BAR; PG8_SCHED;
            PG8_LDB(B1, 1, 1); PG8_STAGE(PG8_SB(1, 0), b3, voffB);
            PG8_BAR; PG8_WAIT_L(0); PG8_MMA(0, 1, At, B1); PG8_BAR;
            PG8_LDA(At, 1, 1); PG8_STAGE(PG8_SA(1, 0), a3, voffA);
            PG8_BAR; PG8_WAIT_L(0); PG8_MMA(1, 0, At, B0); PG8_BAR; PG8_SCHED;
            PG8_STAGE(PG8_SB(1, 1), b3 + hstep, voffB);
            PG8_WAIT_V(6); PG8_BAR; PG8_MMA(1, 1, At, B1); PG8_BAR;
            }
        }
        if constexpr (ALIGN_EPI) { if (wr == 0) PG8_BAR; }
        if constexpr (!Epi::AFTER_DRAIN) { E(acc, cur, wr, wc, fr, fq); S.done(cur); }
        if (!has_next) break;
#pragma unroll
        for (int a = 0; a < 2; ++a)
#pragma unroll
            for (int b = 0; b < 2; ++b)
#pragma unroll
                for (int m = 0; m < 4; ++m)
#pragma unroll
                    for (int n = 0; n < 2; ++n) acc[a][b][m][n] = (f32x4){0.f, 0.f, 0.f, 0.f};
        cur = nxt; cA = nA; cB = nB; ++ui;
        if constexpr (ALIGN_EPI) { if (wr == 1) PG8_BAR; }
    }
    PG8_WAIT_V(0);
    if constexpr (!ALIGN_EPI) { if (wr == 0) PG8_BAR; }
    PG8_BAR;
    if constexpr (Epi::AFTER_DRAIN) { E.fused(acc, cur, wr, wc, fr, fq, lds, wid, lane); S.done(cur); }
#undef PG8_SA
#undef PG8_SB
#undef PG8_STAGE
#undef PG8_LDA
#undef PG8_LDB
#undef PG8_MMA
#undef PG8_WAIT_V
#undef PG8_WAIT_L
#undef PG8_BAR
#undef PG8_SCHED
}
}
#include <hip/hip_bf16.h>
#include <cmath>
namespace attn_body {
using bf16=__hip_bfloat16;
using bf16x8=__attribute__((ext_vector_type(8)))short;
using s16x4=__attribute__((ext_vector_type(4)))short;
using f32x16=__attribute__((ext_vector_type(16)))float;
using u32x4=__attribute__((ext_vector_type(4)))unsigned;
constexpr int BATCH=16,NHEAD=8,SEQ=2048,D=64,PQ=512,PO=1024;
constexpr int NW=8,QBLK=32,QB=QBLK*NW,KVBLK=64,NQB=SEQ/QB;
__device__ __forceinline__ int crow(int r,int hi){return (r&3)+8*(r>>2)+4*hi;}
#define SBAR() __builtin_amdgcn_sched_barrier(0)
__device__ __forceinline__ void cmask(f32x16&p0,f32x16&p1,int jb,int qrel,int hi){
  const float NEG=-INFINITY; int kb=64*jb+4*hi;
  #pragma unroll
  for(int r=0;r<16;++r){int kv=kb+(r&3)+8*(r>>2); if(kv>qrel)p0[r]=NEG; if(kv+32>qrel)p1[r]=NEG;}
}

constexpr int NSLOT=3, SLOTB=8192;
constexpr int LDS_K=0, LDS_V=NSLOT*SLOTB, LDS_WS=2*NSLOT*SLOTB, LDS_OST=LDS_WS+NW*64*4, LDS_BYTES=LDS_OST+NW*4096;
constexpr float C2=0.125f*1.4426950408889634f;
__device__ __forceinline__ void glds16(const void*gsrc,unsigned lds_dst){unsigned keep;
  asm volatile("s_mov_b32 %0, m0\n\ts_mov_b32 m0, %2\n\ts_nop 0\n\tglobal_load_lds_dwordx4 %1, off\n\ts_mov_b32 m0, %0":"=&s"(keep):"v"(gsrc),"s"(lds_dst):"memory");}
__device__ __forceinline__ float max3f(float a,float b,float c){float r;asm("v_max3_f32 %0, %1, %2, %3":"=v"(r):"v"(a),"v"(b),"v"(c));return r;}
__device__ __forceinline__ float max2f(float a,float b){float r;asm("v_max_f32_e32 %0, %1, %2":"=v"(r):"v"(a),"v"(b));return r;}
__device__ __forceinline__ float fadd_s(float a,float b){float r;asm("v_add_f32_e32 %0, %1, %2":"=v"(r):"v"(a),"v"(b));return r;}
__device__ __forceinline__ float fsub_s(float a,float b){float r;asm("v_sub_f32_e32 %0, %1, %2":"=v"(r):"v"(a),"v"(b));return r;}
typedef float f32x4g __attribute__((ext_vector_type(4)));
__device__ __forceinline__ float bfv(short v){return __uint_as_float(((unsigned)(unsigned short)v)<<16);}
typedef float f32x2_t __attribute__((ext_vector_type(2))); typedef __bf16 bf16x2_t __attribute__((ext_vector_type(2)));
__device__ __forceinline__ unsigned cvtpk_s(float lo,float hi){f32x2_t v={lo,hi};bf16x2_t b=__builtin_convertvector(v,bf16x2_t);return __builtin_bit_cast(unsigned,b);}
#define WAIT_BAR(N) asm volatile("s_waitcnt vmcnt(" #N ") lgkmcnt(0)\n\ts_barrier":::"memory")

__device__ __forceinline__ void qkt(f32x16&p0,f32x16&p1,const char*Kslot,const bf16x8*qr,int r32,int hi){
  const char*kb=Kslot+hi*1024+r32*16;
  #pragma unroll
  for(int d0=0;d0<4;++d0){
    const bf16x8 b0=*reinterpret_cast<const bf16x8*>(kb+d0*2048);
    const bf16x8 b1=*reinterpret_cast<const bf16x8*>(kb+d0*2048+512);
    p0=__builtin_amdgcn_mfma_f32_32x32x16_bf16(b0,qr[d0],p0,0,0,0);p1=__builtin_amdgcn_mfma_f32_32x32x16_bf16(b1,qr[d0],p1,0,0,0);}
}
typedef __attribute__((address_space(3))) const char* lds_cptr;
typedef short v4i16_t __attribute__((ext_vector_type(4)));
__device__ __forceinline__ void kload8(bf16x8*kf,lds_cptr kp){
  kf[0]=*(const __attribute__((address_space(3))) bf16x8*)(kp);      kf[1]=*(const __attribute__((address_space(3))) bf16x8*)(kp+512);
  kf[2]=*(const __attribute__((address_space(3))) bf16x8*)(kp+2048); kf[3]=*(const __attribute__((address_space(3))) bf16x8*)(kp+2560);
  kf[4]=*(const __attribute__((address_space(3))) bf16x8*)(kp+4096); kf[5]=*(const __attribute__((address_space(3))) bf16x8*)(kp+4608);
  kf[6]=*(const __attribute__((address_space(3))) bf16x8*)(kp+6144); kf[7]=*(const __attribute__((address_space(3))) bf16x8*)(kp+6656);
}
__device__ __forceinline__ void kload2(bf16x8*kf,lds_cptr kp,int j){ kf[2*j]=*(const __attribute__((address_space(3))) bf16x8*)(kp+j*2048); kf[2*j+1]=*(const __attribute__((address_space(3))) bf16x8*)(kp+j*2048+512); }
__device__ __forceinline__ s16x4 vtr(lds_cptr p){ return __builtin_bit_cast(s16x4,__builtin_amdgcn_ds_read_tr16_b64_v4i16((__attribute__((address_space(3))) v4i16_t*)p)); }
__device__ __forceinline__ float rowmax(const f32x16&p0,const f32x16&p1){
  float a=max3f(p0[0],p0[1],p1[0]),b=max3f(p0[2],p0[3],p1[1]);a=max3f(a,p1[2],p1[3]);
  #pragma unroll
  for(int r=4;r<16;r+=4){a=max3f(a,p0[r],p0[r+1]);b=max3f(b,p0[r+2],p0[r+3]);a=max3f(a,p1[r],p1[r+1]);b=max3f(b,p1[r+2],p1[r+3]);}
  const float m=max2f(a,b);
  auto rr=__builtin_amdgcn_permlane32_swap(__float_as_uint(m),__float_as_uint(m),false,false);
  return max2f(__uint_as_float(rr[0]),__uint_as_float(rr[1]));
}
__device__ __forceinline__ void pv(f32x16*o,int vb,bf16x8 pa0,bf16x8 pa1,bf16x8 pa2,bf16x8 pa3){
  #pragma unroll
  for(int d0=0;d0<2;++d0){s16x4 lo[4],hi[4];
    #pragma unroll
    for(int ks=0;ks<4;++ks){
      asm volatile("ds_read_b64_tr_b16 %0,%1 offset:%c2":"=&v"(lo[ks]):"v"(vb),"i"(d0*4096+ks*1024):"memory");
      asm volatile("ds_read_b64_tr_b16 %0,%1 offset:%c2":"=&v"(hi[ks]):"v"(vb),"i"(d0*4096+ks*1024+512):"memory");}
    asm volatile("s_waitcnt lgkmcnt(0)":::"memory");SBAR();
    #define PK(k) (bf16x8){lo[k][0],lo[k][1],lo[k][2],lo[k][3],hi[k][0],hi[k][1],hi[k][2],hi[k][3]}
    o[d0]=__builtin_amdgcn_mfma_f32_32x32x16_bf16(pa0,PK(0),o[d0],0,0,0);
    o[d0]=__builtin_amdgcn_mfma_f32_32x32x16_bf16(pa1,PK(1),o[d0],0,0,0);
    o[d0]=__builtin_amdgcn_mfma_f32_32x32x16_bf16(pa2,PK(2),o[d0],0,0,0);
    o[d0]=__builtin_amdgcn_mfma_f32_32x32x16_bf16(pa3,PK(3),o[d0],0,0,0);
    #undef PK
  }
}

#ifndef ATTN_STORE16
#define ATTN_STORE16(p,v) (*(u32x4*)(p)=(v))
#endif
template<int THRL> __device__ __forceinline__ void attn_unit(int b,int h,int qb,const bf16*Q,const bf16*__restrict__ K,const bf16*__restrict__ V,bf16*O,float*SSQ,const float*__restrict__ KM,char*shm,const int wv){
  int tid_=wv*64+(int)__builtin_amdgcn_mbcnt_hi(~0u,__builtin_amdgcn_mbcnt_lo(~0u,0u)); asm volatile("":"+v"(tid_)); const int tid=tid_,lane=tid&63,r32=lane&31,hi=lane>>5; const int wid=__builtin_amdgcn_readfirstlane(tid>>6);
  const long rowbase=(long)b*SEQ; const int q0=qb*QB;
  const bf16*Qw=Q+(rowbase+q0+wid*QBLK)*PQ+h*D;
  const bf16*Kh=K+rowbase*PQ+h*D,*Vh=V+rowbase*PQ+h*D;
  const unsigned lds0=(unsigned)(uintptr_t)shm;
  float*wsf=(float*)(shm+LDS_WS)+wid*64;
  const bf16*ksrc=Kh+(long)lane*PQ+wid*8;
  const bf16*vsrc=Vh+(long)(16*(wid&3)+(lane>>2))*PQ+(wid>>2)*32+(lane&3)*8;
  const unsigned kdst=lds0+LDS_K+wid*1024, vdst=lds0+LDS_V+wid*1024;
  #define KT(t) (((t)<4)?(4*qb+(t)):((t)-4))
  #define DMA_K(t,slot) glds16(ksrc+(long)KT(t)*KVBLK*PQ,(unsigned)__builtin_amdgcn_readfirstlane(kdst+(slot)))
  #define DMA_V(t,slot) glds16(vsrc+(long)KT(t)*KVBLK*PQ,(unsigned)__builtin_amdgcn_readfirstlane(vdst+(slot)))
  const int vb0=(int)(lds0+LDS_V)+((lane>>4)&1)*32+(lane&3)*8+(4*hi+((lane&15)>>2))*64;
  const char*Kbase=shm+LDS_K; bf16x8 kf[8];
  const lds_cptr shm3=(lds_cptr)shm; const lds_cptr kp0=shm3+LDS_K+hi*1024+r32*16; const lds_cptr vp0=shm3+LDS_V+((lane>>4)&1)*32+(lane&3)*8+(4*hi+((lane&15)>>2))*64;
  const int NT=(q0+QB)/KVBLK;
  DMA_K(0,0);DMA_V(0,0);DMA_K(1,SLOTB);
  bf16x8 qr[4];
  #pragma unroll
  for(int d0=0;d0<4;++d0)qr[d0]=*reinterpret_cast<const bf16x8*>(&Qw[(long)r32*PQ+d0*16+hi*8]);
  unsigned selm=0u;
  if(qb>0){ float gsc[7];
    #pragma unroll
    for(int n=0;n<7;++n){ float a=0.f;
      if(n<qb){ const float*km=KM+((long)((b*NHEAD+h)*NQB+n))*D+8*hi;
        #pragma unroll
        for(int d0=0;d0<4;++d0){ const f32x4g k0=*(const f32x4g*)(km+16*d0), k1=*(const f32x4g*)(km+16*d0+4);
          a+=bfv(qr[d0][0])*k0[0]+bfv(qr[d0][1])*k0[1]+bfv(qr[d0][2])*k0[2]+bfv(qr[d0][3])*k0[3]+bfv(qr[d0][4])*k1[0]+bfv(qr[d0][5])*k1[1]+bfv(qr[d0][6])*k1[2]+bfv(qr[d0][7])*k1[3]; } }
      {auto rr_=__builtin_amdgcn_permlane32_swap(__float_as_uint(a),__float_as_uint(a),false,false); a=__uint_as_float(rr_[0])+__uint_as_float(rr_[1]);} gsc[n]=(n<qb)?a:-INFINITY; }
    #pragma unroll
    for(int k=0;k<3;++k){ int best=-1; float bv=-INFINITY;
      #pragma unroll
      for(int n=0;n<7;++n) if(!((selm>>n)&1u)&&gsc[n]>bv){bv=gsc[n];best=n;}
      if(best>=0)selm|=1u<<best; } }
  const float sl2=__builtin_amdgcn_exp2f(-(float)(h+1))*1.4426950408889634f, sl32=32.f*sl2, cbase=(float)(4*hi)*sl2;
  float mhat=0.f,l_reg=0.f;f32x16 o[2];o[0]=f32x16{};o[1]=f32x16{};
  #define CIN(C0,C1,t) do{ float cl_=cbase+(float)(KT(t)*KVBLK-q0)*sl2-mhat; if((t)>=4){ if(!((selm>>(((t)>=4?(t)-4:0)>>2))&1u)) cl_=-INFINITY; } const float cl1_=cl_+sl32; \
    _Pragma("unroll") for(int r=0;r<16;++r){C0[r]=__builtin_fmaf(sl2,(float)((r&3)+8*(r>>2)),cl_);C1[r]=__builtin_fmaf(sl2,(float)((r&3)+8*(r>>2)),cl1_);} }while(0)
  const int qrel=wid*QBLK+r32;
  #define CMASK(P0,P1,t) do{ if((t)<4)cmask(P0,P1,(t),qrel,hi); }while(0)
  bool resc=false;
  #define START(P0,P1) do{ const float rm=rowmax(P0,P1); resc=false; \
    { const float dl=rm; mhat=fadd_s(mhat,dl); \
      _Pragma("unroll") for(int r=0;r<16;++r){P0[r]=fsub_s(P0[r],dl);P1[r]=fsub_s(P1[r],dl);} } \
    _Pragma("unroll") for(int r=0;r<16;++r)P0[r]=__builtin_amdgcn_exp2f(P0[r]); }while(0)
  #define RESC() do{ if(resc){ asm volatile("s_waitcnt lgkmcnt(0)":::"memory"); \
      _Pragma("unroll") for(int d_=0;d_<2;++d_) _Pragma("unroll") for(int r=0;r<16;++r)o[d_][r]*=wsf[crow(r,hi)]; } }while(0)
  f32x16 pA0,pA1,pB0,pB1;
  int sl_prev=0,sl_cur=0,sl_next=SLOTB;
  #define ROT() do{sl_prev=sl_cur;sl_cur=sl_next;sl_next=(sl_next==(NSLOT-1)*SLOTB)?0:sl_next+SLOTB;}while(0)
  DMA_K(2,2*SLOTB);
  WAIT_BAR(3);
  CIN(pA0,pA1,0); qkt(pA0,pA1,Kbase,qr,r32,hi);asm volatile("s_nop 15\n\ts_nop 7":"+v"(pA0),"+v"(pA1));CMASK(pA0,pA1,0);
  START(pA0,pA1);
  _Pragma("unroll") for(int r=0;r<16;++r)pA1[r]=__builtin_amdgcn_exp2f(pA1[r]);
  WAIT_BAR(0);
  DMA_K(3,0);DMA_V(1,SLOTB);
  ROT();
  kload8(kf,kp0+sl_cur);
  WAIT_BAR(2);
  s16x4 vlo[8],vhi[8]; u32x4 pw0,pw1,pw2,pw3;
  #define PKW(P,B) cvtpk_s(P[B],P[B+1])
  #define PAF(k) __builtin_bit_cast(bf16x8,pw##k)
  #define VFR(i) (bf16x8){vlo[i][0],vlo[i][1],vlo[i][2],vlo[i][3],vhi[i][0],vhi[i][1],vhi[i][2],vhi[i][3]}
  #define PIN(x) asm volatile("":"+v"(x))
  #define MX3(a,b,c) __builtin_fmaxf(__builtin_fmaxf((a),(b)),(c))
  #define GAPA(MF,A0,A1,A2,A3,W0,W1,PW) do{ MF; sacc+=A0; sacc+=A1; sacc+=A2; sacc+=A3; PIN(sacc); W0; W1; PIN(PW); SBAR(); }while(0)
  #define EX(v) __builtin_amdgcn_exp2f(v)
  #define GAPB(MF,X,B) do{ MF; X[B]=EX(X[B]); X[B+1]=EX(X[B+1]); X[B+2]=EX(X[B+2]); X[B+3]=EX(X[B+3]); PIN(X); SBAR(); }while(0)
  #define VRD(i) do{ vlo[i]=vtr(vp_+(((i)>>2)*4096+((i)&3)*1024)); vhi[i]=vtr(vp_+(((i)>>2)*4096+((i)&3)*1024+512)); }while(0)
  #define KRD(G,j) do{ if(G){ kload2(kf,kp0+sl_next,j); SBAR(); } }while(0)
  #define STEP(C0,C1,P0,P1,t,GK,GV,GL) do{ SBAR(); CIN(C0,C1,t); SBAR(); \
    const lds_cptr vp_=vp0+sl_prev; \
    VRD(0); SBAR(); float sacc=(P0[0]+P0[1]); \
    GAPA(C0=__builtin_amdgcn_mfma_f32_32x32x16_bf16(kf[0],qr[0],C0,0,0,0), P0[2],P0[3],P0[4],P0[5],     pw0[0]=PKW(P0,0), pw0[1]=PKW(P0,2), pw0); \
    VRD(4); SBAR(); GAPA(C1=__builtin_amdgcn_mfma_f32_32x32x16_bf16(kf[1],qr[0],C1,0,0,0), P0[6],P0[7],P0[8],P0[9],     pw0[2]=PKW(P0,4), pw0[3]=PKW(P0,6), pw0); \
    VRD(1); SBAR(); GAPA(C0=__builtin_amdgcn_mfma_f32_32x32x16_bf16(kf[2],qr[1],C0,0,0,0),   P0[10],P0[11],P0[12],P0[13], pw1[0]=PKW(P0,8), pw1[1]=PKW(P0,10), pw1); \
    VRD(5); SBAR(); GAPA(C1=__builtin_amdgcn_mfma_f32_32x32x16_bf16(kf[3],qr[1],C1,0,0,0),   P0[14],P0[15],P1[0],P1[1],   pw1[2]=PKW(P0,12),pw1[3]=PKW(P0,14), pw1); \
    VRD(2); SBAR(); GAPA(C0=__builtin_amdgcn_mfma_f32_32x32x16_bf16(kf[4],qr[2],C0,0,0,0),   P1[2],P1[3],P1[4],P1[5],     pw2[0]=PKW(P1,0), pw2[1]=PKW(P1,2), pw2); \
    VRD(6); SBAR(); GAPA(C1=__builtin_amdgcn_mfma_f32_32x32x16_bf16(kf[5],qr[2],C1,0,0,0),   P1[6],P1[7],P1[8],P1[9],     pw2[2]=PKW(P1,4), pw2[3]=PKW(P1,6), pw2); \
    VRD(3); SBAR(); GAPA(C0=__builtin_amdgcn_mfma_f32_32x32x16_bf16(kf[6],qr[3],C0,0,0,0),   P1[10],P1[11],P1[12],P1[13], pw3[0]=PKW(P1,8), pw3[1]=PKW(P1,10), pw3); \
    VRD(7); SBAR(); GAPA(C1=__builtin_amdgcn_mfma_f32_32x32x16_bf16(kf[7],qr[3],C1,0,0,0),   P1[14],P1[15],0.f,0.f,       pw3[2]=PKW(P1,12),pw3[3]=PKW(P1,14), pw3); \
    l_reg+=sacc; \
    if(GK){DMA_K((t)+3,sl_cur);} if(GV){DMA_V((t)+1,sl_next);} \
    CMASK(C0,C1,t); \
    { float a=MX3(C0[0],C0[1],C1[0]),b=MX3(C0[2],C0[3],C1[1]); a=MX3(a,C1[2],C1[3]); \
      _Pragma("unroll") for(int r=4;r<16;r+=4){a=MX3(a,C0[r],C0[r+1]);b=MX3(b,C0[r+2],C0[r+3]);a=MX3(a,C1[r],C1[r+1]);b=MX3(b,C1[r+2],C1[r+3]);} \
      float rm=__builtin_fmaxf(a,b); { auto rr=__builtin_amdgcn_permlane32_swap(__float_as_uint(rm),__float_as_uint(rm),false,false); rm=__builtin_fmaxf(__uint_as_float(rr[0]),__uint_as_float(rr[1])); } \
      resc=false; \
      if(__builtin_expect(__any(rm>(float)THRL),0)){ const float dl=__builtin_fmaxf(rm,0.f); mhat+=dl; \
        _Pragma("unroll") for(int r=0;r<16;++r){C0[r]-=dl;C1[r]-=dl;} \
        const float f=__builtin_amdgcn_exp2f(-dl); l_reg*=f; if(hi==0)wsf[r32]=f; resc=true; } } \
    SBAR(); \
    GAPB(o[0]=__builtin_amdgcn_mfma_f32_32x32x16_bf16(PAF(0),VFR(0),o[0],0,0,0), C0,0); \
    GAPB(o[1]=__builtin_amdgcn_mfma_f32_32x32x16_bf16(PAF(0),VFR(4),o[1],0,0,0), C0,4); \
    KRD(GL,0); GAPB(o[0]=__builtin_amdgcn_mfma_f32_32x32x16_bf16(PAF(1),VFR(1),o[0],0,0,0), C0,8); \
    KRD(GL,1); GAPB(o[1]=__builtin_amdgcn_mfma_f32_32x32x16_bf16(PAF(1),VFR(5),o[1],0,0,0), C0,12); \
    KRD(GL,2); GAPB(o[0]=__builtin_amdgcn_mfma_f32_32x32x16_bf16(PAF(2),VFR(2),o[0],0,0,0), C1,0); \
    KRD(GL,3); GAPB(o[1]=__builtin_amdgcn_mfma_f32_32x32x16_bf16(PAF(2),VFR(6),o[1],0,0,0), C1,4); \
    GAPB(o[0]=__builtin_amdgcn_mfma_f32_32x32x16_bf16(PAF(3),VFR(3),o[0],0,0,0), C1,8); \
    GAPB(o[1]=__builtin_amdgcn_mfma_f32_32x32x16_bf16(PAF(3),VFR(7),o[1],0,0,0), C1,12); \
    }while(0)
  int t=1;
  #define ENDW(tt) do{ if((tt)+3<NT){WAIT_BAR(2);} else if((tt)+2<NT){WAIT_BAR(1);} else {WAIT_BAR(0);} }while(0)
  for(;t+1<NT;t+=2){
    STEP(pB0,pB1,pA0,pA1,t,(t+3<NT),(t+1<NT),(t+1<NT));       ENDW(t);   RESC(); ROT();
    STEP(pA0,pA1,pB0,pB1,t+1,(t+4<NT),(t+2<NT),(t+2<NT));     ENDW(t+1); RESC(); ROT();
  }
  STEP(pB0,pB1,pA0,pA1,NT-1,false,false,false); RESC();
  { float sacc=pB0[0]+pB0[1]; _Pragma("unroll") for(int r=2;r<16;++r)sacc+=pB0[r]; _Pragma("unroll") for(int r=0;r<16;++r)sacc+=pB1[r]; l_reg+=sacc;
    pw0=(u32x4){PKW(pB0,0),PKW(pB0,2),PKW(pB0,4),PKW(pB0,6)};pw1=(u32x4){PKW(pB0,8),PKW(pB0,10),PKW(pB0,12),PKW(pB0,14)};pw2=(u32x4){PKW(pB1,0),PKW(pB1,2),PKW(pB1,4),PKW(pB1,6)};pw3=(u32x4){PKW(pB1,8),PKW(pB1,10),PKW(pB1,12),PKW(pB1,14)};
    SBAR(); pv(o,vb0+sl_cur,PAF(0),PAF(1),PAF(2),PAF(3)); }
  #undef PKW
  #undef PAF
  #undef VFR
  #undef PIN
  #undef MX3
  #undef GAPA
  #undef GAPB
  #undef EX
  #undef VRD
  #undef KRD
  #undef STEP
  #undef ENDW
  {auto rr=__builtin_amdgcn_permlane32_swap(__float_as_uint(l_reg),__float_as_uint(l_reg),false,false);l_reg=__uint_as_float(rr[0])+__uint_as_float(rr[1]);}
  if(hi==0)wsf[32+r32]=l_reg;asm volatile("s_waitcnt lgkmcnt(0)":::"memory");
  float rli[16];
  #pragma unroll
  for(int r=0;r<16;++r)rli[r]=__builtin_amdgcn_rcpf(wsf[32+crow(r,hi)]);
  bf16*Ow=O+(rowbase+q0+wid*QBLK)*PO+h*D; float*Sw=SSQ+(rowbase+q0+wid*QBLK)*NHEAD+h;
  { bf16*stg=(bf16*)(shm+LDS_OST)+wid*2048;
    #pragma unroll
    for(int r=0;r<16;++r){const int orow=crow(r,hi);
      #pragma unroll
      for(int d0=0;d0<2;++d0)stg[orow*64+d0*32+r32]=__float2bfloat16(o[d0][r]*rli[r]);}
    asm volatile("s_waitcnt lgkmcnt(0)":::"memory");
    #pragma unroll
    for(int i=0;i<4;++i){const int row=i*8+(lane>>3),ch=lane&7; const u32x4 v=*(const u32x4*)(stg+row*64+ch*8); ATTN_STORE16(Ow+(long)row*PO+ch*8,v);
      float ss=0.f;
      #pragma unroll
      for(int k=0;k<4;++k){const float lo=__uint_as_float(v[k]<<16),hh=__uint_as_float(v[k]&0xffff0000u); ss+=lo*lo+hh*hh;}
      ss+=__uint_as_float((unsigned)__builtin_amdgcn_ds_swizzle((int)__float_as_uint(ss),(1<<10)|0x1f));ss+=__uint_as_float((unsigned)__builtin_amdgcn_ds_swizzle((int)__float_as_uint(ss),(2<<10)|0x1f));ss+=__uint_as_float((unsigned)__builtin_amdgcn_ds_swizzle((int)__float_as_uint(ss),(4<<10)|0x1f)); if(ch==0)Sw[(long)row*NHEAD]=ss;} }
  asm volatile("s_waitcnt lgkmcnt(0)\n\ts_barrier":::"memory");
  #undef DMA_K
  #undef KT
  #undef CIN
  #undef DMA_V
  #undef CMASK
  #undef START
  #undef RESC
  #undef ROT
}
constexpr int ATTN_LDS_BYTES=LDS_BYTES;
struct AttnTensors { const bf16* Q; const bf16* K; const bf16* V; bf16* O; float* SSQ; const float* KM; };
struct AttnUnit { int bh; int qb; };
struct MobaOrder {
  int vcu,G;
  __device__ __forceinline__ explicit MobaOrder(int grid,int block):vcu((grid%8==0)?(block%8)*(grid/8)+block/8:block),G(grid){}
  __device__ __forceinline__ bool next(int i,AttnUnit&u)const{ const int L=(i>>2)*G+vcu; if(L>=BATCH*NHEAD*2)return false; const int s=2*(L&1)+((i>>1)&1); u.bh=L>>1; u.qb=(i&1)?7-s:s; return true; }
};
template<class Sched,int THRL=8> __device__ __forceinline__ void attn_phase(char*lds,const AttnTensors&T,const Sched&S,const int wv){
  AttnUnit u;
  for(int i=0;S.next(i,u);++i){ attn_unit<THRL>(u.bh/NHEAD,u.bh%NHEAD,u.qb,T.Q,T.K,T.V,T.O,T.SSQ,T.KM,lds,wv); }
}
#undef SBAR
#undef WAIT_BAR
}
#define GAS __attribute__((address_space(1)))
#define LAS __attribute__((address_space(3)))
typedef unsigned short bf16;
typedef unsigned v4u __attribute__((ext_vector_type(4)));
typedef float f32x4 __attribute__((ext_vector_type(4)));
typedef short bf16x8 __attribute__((ext_vector_type(8)));
typedef GAS unsigned gu32;
typedef GAS unsigned long long gu64;
#define RLX_AGENT __ATOMIC_RELAXED, __HIP_MEMORY_SCOPE_AGENT
__device__ __forceinline__ int hw_lane() { return (int)__builtin_amdgcn_mbcnt_hi(~0u, __builtin_amdgcn_mbcnt_lo(~0u, 0u)); }
template <int K> __device__ __forceinline__ float xadd(float v) {
    if constexpr (K < 32) return v + __uint_as_float((unsigned)__builtin_amdgcn_ds_swizzle((int)__float_as_uint(v), (K << 10) | 0x1f));
    else { auto rr = __builtin_amdgcn_permlane32_swap(__float_as_uint(v), __float_as_uint(v), false, false); return __uint_as_float(rr[0]) + __uint_as_float(rr[1]); }
}
template <int K> __device__ __forceinline__ float xmax(float v) {
    if constexpr (K < 32) return fmaxf(v, __uint_as_float((unsigned)__builtin_amdgcn_ds_swizzle((int)__float_as_uint(v), (K << 10) | 0x1f)));
    else { auto rr = __builtin_amdgcn_permlane32_swap(__float_as_uint(v), __float_as_uint(v), false, false); return fmaxf(__uint_as_float(rr[0]), __uint_as_float(rr[1])); }
}
#define LDS_WAIT() asm volatile("s_waitcnt lgkmcnt(0)" ::: "memory")
#define VM_WAIT() asm volatile("s_waitcnt vmcnt(0)" ::: "memory")
__device__ __forceinline__ unsigned long long rt() { return __builtin_amdgcn_s_memrealtime(); }
__device__ __forceinline__ unsigned f2bf(float f) { unsigned u = __builtin_bit_cast(unsigned, f); return (u + 0x7fffu + ((u >> 16) & 1u)) >> 16; }
__device__ __forceinline__ unsigned pk2(float lo, float hi) { return f2bf(lo) | (f2bf(hi) << 16); }

#define XB_TMO      128
#define XB_XCNT(j)  (256  + 64 * (j))
#define XB_XSUB(j)  (1280 + 64 * (j))
#define XB_XGEN(j)  (2304 + 64 * (j))
#define XB_TOP      3328
#define XB_TOPGEN   3392
#define XCD_BAR_WORDS 3456
#define XB_SPIN_CAP (1u << 18)

__device__ __forceinline__ unsigned xb_ld(unsigned* p)              { return __hip_atomic_load(p, __ATOMIC_RELAXED, __HIP_MEMORY_SCOPE_AGENT); }
__device__ __forceinline__ unsigned xb_add(unsigned* p, unsigned v) { return __hip_atomic_fetch_add(p, v, __ATOMIC_RELAXED, __HIP_MEMORY_SCOPE_AGENT); }
__device__ __forceinline__ unsigned xb_xcc_id() { return (unsigned)__builtin_amdgcn_s_getreg((3 << 11) | 20) & 0xFu; }
#define XB_SPIN(cond, bar) do { unsigned _sp = 0; while (cond) { __builtin_amdgcn_s_sleep(1); \
    if ((++_sp & 255u) == 0u) { if (xb_ld(&(bar)[XB_TMO])) break; if (_sp > XB_SPIN_CAP) { atomicAdd(&(bar)[XB_TMO], 1u); break; } } } } while (0)

struct XcdBarrier {
    unsigned* bar; unsigned x;
    volatile LAS unsigned* st;
};

__device__ __forceinline__ XcdBarrier xcd_barrier_post(unsigned* bar, volatile LAS unsigned* st, bool leader) {
    XcdBarrier b; b.bar = bar; b.x = xb_xcc_id(); b.st = st;
    if (leader) (void)xb_add(&bar[XB_XCNT(b.x)], 1u);
    return b;
}
__device__ __forceinline__ void xcd_barrier_complete(unsigned* bar, unsigned x, unsigned& nloc, unsigned& nx) {
    const unsigned G = gridDim.x * gridDim.y * gridDim.z;
    unsigned sum, cnt, mine, sp = 0u;
    for (;;) {
        sum = 0u; cnt = 0u; mine = 0u;
#pragma unroll
        for (unsigned j = 0; j < 16; ++j) { const unsigned c = xb_ld(&bar[XB_XCNT(j)]); sum += c; cnt += (c > 0u) ? 1u : 0u; mine = (j == x) ? c : mine; }
        if (sum == G) break;
        __builtin_amdgcn_s_sleep(1);
        if ((++sp & 255u) == 0u) { if (xb_ld(&bar[XB_TMO])) break; if (sp > XB_SPIN_CAP) { atomicAdd(&bar[XB_TMO], 1u); break; } }
    }
    nloc = mine > 0u ? mine : 1u; nx = cnt > 0u ? cnt : 1u;
}

__device__ __forceinline__ void xcd_barrier(const XcdBarrier& b, bool leader) {
    asm volatile("s_waitcnt vmcnt(0)" ::: "memory");
    __syncthreads();
    if (leader) {
        unsigned* bar = b.bar;
        __builtin_amdgcn_s_waitcnt(0);
        unsigned nloc = b.st[0], nx = b.st[1];
        if (nloc == 0u) { xcd_barrier_complete(bar, b.x, nloc, nx); b.st[0] = nloc; b.st[1] = nx; }
        const unsigned old = xb_add(&bar[XB_XSUB(b.x)], 1u);
        const unsigned gen = old / nloc;
        if (old + 1u == (gen + 1u) * nloc) {
            __builtin_amdgcn_fence(__ATOMIC_RELEASE, "agent");
            asm volatile("s_waitcnt vmcnt(0)" ::: "memory");
            const unsigned og = xb_add(&bar[XB_TOP], 1u);
            const unsigned tg = og / nx;
            if (og + 1u == (tg + 1u) * nx) xb_add(&bar[XB_TOPGEN], 1u);
            else XB_SPIN(xb_ld(&bar[XB_TOPGEN]) == tg, bar);
            __builtin_amdgcn_fence(__ATOMIC_ACQUIRE, "agent");
            xb_add(&bar[XB_XGEN(b.x)], 1u);
            asm volatile("s_waitcnt vmcnt(0)" ::: "memory");
        } else {
            XB_SPIN(xb_ld(&bar[XB_XGEN(b.x)]) == gen, bar);
            __builtin_amdgcn_fence(__ATOMIC_ACQUIRE, "agent");
            asm volatile("s_waitcnt vmcnt(0)" ::: "memory");
        }
    }
    __syncthreads();
}

constexpr int NWAVES = 8;
constexpr int DM = 1024, BATCH = 16, SEQ = 2048, DEPTH = 2, HD = 64, NH = 8, NGRP = 8, AW = 512, GWD = 512, INW = 2560, MOBA = 256, NBLK = SEQ / MOBA, GCH = 128, DFF = 2816, PLE = 256;
constexpr int M = BATCH * SEQ;
constexpr float RMS_EPS = 1e-6f, LN_EPS = 1e-5f;
constexpr float LOG2E = 1.4426950408889634f;
constexpr float QSCALE = 0.125f * LOG2E;

constexpr size_t MiB = 1u << 20;
constexpr size_t WS_CTL = 0, CTL_ZERO_BYTES = 1 * MiB;
constexpr size_t WL_GU1 = 0, WL_D1 = WL_GU1 + (size_t)2 * DFF * DM * 2, WL_GU2 = WL_D1 + (size_t)DM * DFF * 2, WL_D2 = WL_GU2 + (size_t)2 * DFF * DM * 2,
                 WL_IN = WL_D2 + (size_t)DM * DFF * 2, WL_OUT = WL_IN + (size_t)INW * DM * 2, WL_PG = WL_OUT + (size_t)DM * DM * 2, WL_PP = WL_PG + (size_t)DM * DM * 2, WL_STRIDE = WL_PP + (size_t)DM * PLE * 2;
constexpr size_t WS_W = 2 * MiB;
static_assert(WS_W + 2 * WL_STRIDE <= 88 * MiB, "weights");
constexpr size_t WS_PBF = 88 * MiB;
constexpr size_t WS_XN = 120 * MiB;
constexpr size_t WS_HB = 184 * MiB;
constexpr size_t WS_MRG = 360 * MiB;
constexpr size_t WS_FB = 424 * MiB;
constexpr size_t WS_KM = 488 * MiB;
constexpr size_t WS_WSB = 488 * MiB + 512 * 1024;
constexpr size_t WS_SSQ = 489 * MiB;
constexpr size_t WS_RS = 490 * MiB;
constexpr size_t WS_END = 491 * MiB;
constexpr size_t ZSTRIDE = (size_t)M * 512;
static_assert(WS_HB + (size_t)M * DFF * 2 <= WS_MRG && 5 * ZSTRIDE * 2 <= (size_t)M * DFF * 2, "overlay");
constexpr int CW_TMO = 0, CW_CODE = 1, CW_BAR = 4096;

constexpr int RING_OFF = 0, RING_BYTES = 131072;
constexpr int LDSCTL_OFF = RING_BYTES, MISC_OFF = LDSCTL_OFF + 320, EXTRA_OFF = RING_BYTES + 1024;
constexpr int LDS_BYTES = 147456;

struct Frame {
    LAS unsigned char* lds;
    volatile LAS unsigned* MISC;
    gu32* ctl;
    int tid, lane, wave, G;
    float* out; unsigned char* ws;
};
enum { I_X = 0, I_P, I_F1PRE, I_F1G, I_F1U, I_F1D, I_F1POST, I_MIXPRE, I_WIN, I_LNG, I_LNB, I_WS, I_BS, I_AON, I_GON, I_WOUT, I_MIXPOST, I_F2PRE, I_F2G, I_F2U, I_F2D, I_F2POST, I_PLEPRE, I_PLEG, I_PLEP, I_PLEPOST };

__device__ __forceinline__ float wave_sum(float v) { v = xadd<1>(v); v = xadd<2>(v); v = xadd<4>(v); v = xadd<8>(v); v = xadd<16>(v); return xadd<32>(v); }
__device__ __forceinline__ float wave_max(float v) { v = xmax<1>(v); v = xmax<2>(v); v = xmax<4>(v); v = xmax<8>(v); v = xmax<16>(v); return xmax<32>(v); }
__device__ __forceinline__ float bf2f(bf16 b) { return __uint_as_float((unsigned)b << 16); }
__device__ __forceinline__ int fresh_lane() { int l = hw_lane(); asm volatile("" : "+v"(l)); return l; }

__device__ __forceinline__ void p0_transpose_item(const float* W, int K, int N, bf16* WT, LAS float* scr, int k0, int n0, int drow0, const float* gk, int lane) {
#pragma unroll 8
    for (int i = 0; i < 32; ++i) { const int kk = 2 * i + (lane >> 5); const float g = gk ? gk[kk] : 1.0f; scr[kk * 33 + (lane & 31)] = W[(size_t)(k0 + kk) * N + n0 + (lane & 31)] * g; }
    LDS_WAIT(); asm volatile("" ::: "memory");
    const int c = lane & 7;
#pragma unroll
    for (int j = 0; j < 4; ++j) { const int n = (lane >> 3) + 8 * j; const LAS float* s = scr + (8 * c) * 33 + n;
        v4u o; o.x = pk2(s[0 * 33], s[1 * 33]); o.y = pk2(s[2 * 33], s[3 * 33]); o.z = pk2(s[4 * 33], s[5 * 33]); o.w = pk2(s[6 * 33], s[7 * 33]);
        *(GAS v4u*)(WT + (size_t)(drow0 + n) * K + k0 + 8 * c) = o; }
    LDS_WAIT(); asm volatile("" ::: "memory");
}
__device__ __forceinline__ bool p0_matrix(int& r, const float* W, int K, int N, bf16* WT, int mode, const float* gain, const float* gain2, LAS float* scr, int lane) {
    const int nblk = N / 32, items = (K / 64) * nblk;
    if (r >= items) { r -= items; return false; }
    const int kb = r / nblk, nb = r % nblk, k0 = 64 * kb, n0 = 32 * nb;
    const int drow0 = (mode == 0) ? n0 : ((n0 >> 7) * 256 + (n0 & 127) + (mode == 2 ? 128 : 0));
    const float* gk = gain ? ((gain2 && k0 >= 512) ? gain2 + (k0 - 512) : gain + k0) : nullptr;
    p0_transpose_item(W, K, N, WT, scr, k0, n0, drow0, gk, lane);
    return true;
}
__device__ __forceinline__ void row_to_stream(const float* xrow, bf16* orow, float* rs, int lane) {
    const GAS f32x4* xr = (const GAS f32x4*)xrow + lane;
    f32x4 v[4]; float s = 0.f;
#pragma unroll
    for (int j = 0; j < 4; ++j) { v[j] = xr[64 * j]; s += (v[j].x * v[j].x + v[j].y * v[j].y) + (v[j].z * v[j].z + v[j].w * v[j].w); }
    const float r = 1.0f / sqrtf(wave_sum(s) * (1.f / DM) + RMS_EPS);
    GAS unsigned long long* o8 = (GAS unsigned long long*)orow + lane;
#pragma unroll
    for (int j = 0; j < 4; ++j) o8[64 * j] = (unsigned long long)pk2(v[j].x, v[j].y) | ((unsigned long long)pk2(v[j].z, v[j].w) << 32);
    if (lane == 0) *rs = r;
}
struct Args { const float* in[26]; float* out; unsigned char* ws; };
__device__ __forceinline__ void p0_prologue(Frame& F, const Args& A) {
    LAS float* scr = (LAS float*)(F.lds + RING_OFF + F.wave * 16384);
    const int gw = blockIdx.x * NWAVES + F.wave, NGW = F.G * NWAVES;
    constexpr int ITEMS_L = 4 * (DM / 64) * (DFF / 32) + 2 * (DFF / 64) * (DM / 32) + (DM / 64) * (INW / 32) + 2 * (DM / 64) * (DM / 32) + (PLE / 64) * (DM / 32);
    for (int it = gw; it < DEPTH * ITEMS_L; it += NGW) {
        const int l = it / ITEMS_L; int r = it % ITEMS_L;
        bf16* wl = (bf16*)(F.ws + WS_W + (size_t)l * WL_STRIDE);
        if (p0_matrix(r, A.in[I_F1G] + (size_t)l * DM * DFF, DM, DFF, wl + WL_GU1 / 2, 1, A.in[I_F1PRE] + l * DM, nullptr, scr, F.lane)) continue;
        if (p0_matrix(r, A.in[I_F1U] + (size_t)l * DM * DFF, DM, DFF, wl + WL_GU1 / 2, 2, A.in[I_F1PRE] + l * DM, nullptr, scr, F.lane)) continue;
        if (p0_matrix(r, A.in[I_F1D] + (size_t)l * DFF * DM, DFF, DM, wl + WL_D1 / 2, 0, nullptr, nullptr, scr, F.lane)) continue;
        if (p0_matrix(r, A.in[I_F2G] + (size_t)l * DM * DFF, DM, DFF, wl + WL_GU2 / 2, 1, A.in[I_F2PRE] + l * DM, nullptr, scr, F.lane)) continue;
        if (p0_matrix(r, A.in[I_F2U] + (size_t)l * DM * DFF, DM, DFF, wl + WL_GU2 / 2, 2, A.in[I_F2PRE] + l * DM, nullptr, scr, F.lane)) continue;
        if (p0_matrix(r, A.in[I_F2D] + (size_t)l * DFF * DM, DFF, DM, wl + WL_D2 / 2, 0, nullptr, nullptr, scr, F.lane)) continue;
        if (p0_matrix(r, A.in[I_WIN] + (size_t)l * DM * INW, DM, INW, wl + WL_IN / 2, 0, A.in[I_MIXPRE] + l * DM, nullptr, scr, F.lane)) continue;
        if (p0_matrix(r, A.in[I_WOUT] + (size_t)l * DM * DM, DM, DM, wl + WL_OUT / 2, 0, A.in[I_AON] + l * AW, A.in[I_GON] + l * GWD, scr, F.lane)) continue;
        if (p0_matrix(r, A.in[I_PLEG] + (size_t)l * DM * DM, DM, DM, wl + WL_PG / 2, 0, A.in[I_PLEPRE] + l * DM, nullptr, scr, F.lane)) continue;
        p0_matrix(r, A.in[I_PLEP] + (size_t)l * PLE * DM, PLE, DM, wl + WL_PP / 2, 0, nullptr, nullptr, scr, F.lane);
    }
    { const float* wsrc = A.in[I_WS]; bf16* wdst = (bf16*)(F.ws + WS_WSB);
      for (int i = blockIdx.x * (NWAVES * 64) + F.tid; i < DEPTH * NGRP * GCH * GCH; i += F.G * NWAVES * 64) { const int sidx = i & (GCH - 1), tidx = (i >> 7) & (GCH - 1); wdst[i] = (sidx <= tidx) ? (bf16)f2bf(wsrc[i]) : (bf16)0; } }
    { const GAS f32x4* p4 = (const GAS f32x4*)A.in[I_P]; GAS v4u* o = (GAS v4u*)(F.ws + WS_PBF); const int n8 = DEPTH * M * PLE / 8;
      for (int i = blockIdx.x * (NWAVES * 64) + F.tid; i < n8; i += F.G * NWAVES * 64) { const f32x4 a = p4[2 * i], b = p4[2 * i + 1]; v4u w; w.x = pk2(a.x, a.y); w.y = pk2(a.z, a.w); w.z = pk2(b.x, b.y); w.w = pk2(b.z, b.w); o[i] = w; } }
    for (int m = gw; m < M; m += NGW) row_to_stream(A.in[I_X] + (size_t)m * DM, (bf16*)(F.ws + WS_XN) + (size_t)m * DM, (float*)(F.ws + WS_RS) + m, F.lane);
}

__device__ __forceinline__ void thin_phase(Frame& F, const bf16* Fb, bf16* hs, float* rs, const float* gpost, float coef, float* outf) {
    const int gw = blockIdx.x * NWAVES + F.wave, NGW = F.G * NWAVES, lane = fresh_lane();
    f32x4 gp[4];
#pragma unroll
    for (int j = 0; j < 4; ++j) gp[j] = *((const GAS f32x4*)gpost + lane + 64 * j);
    for (int m = gw; m < M; m += NGW) {
        const GAS unsigned long long* fr = (const GAS unsigned long long*)(Fb + (size_t)m * DM) + lane;
        GAS unsigned long long* hr = (GAS unsigned long long*)(hs + (size_t)m * DM) + lane;
        f32x4 f[4], h[4]; float s = 0.f;
#pragma unroll
        for (int j = 0; j < 4; ++j) { const unsigned long long w = fr[64 * j], hw = hr[64 * j];
            f[j].x = __uint_as_float((unsigned)w << 16); f[j].y = __uint_as_float((unsigned)w & 0xffff0000u); f[j].z = __uint_as_float((unsigned)(w >> 32) << 16); f[j].w = __uint_as_float((unsigned)(w >> 32) & 0xffff0000u);
            h[j].x = __uint_as_float((unsigned)hw << 16); h[j].y = __uint_as_float((unsigned)hw & 0xffff0000u); h[j].z = __uint_as_float((unsigned)(hw >> 32) << 16); h[j].w = __uint_as_float((unsigned)(hw >> 32) & 0xffff0000u);
            s += (f[j].x * f[j].x + f[j].y * f[j].y) + (f[j].z * f[j].z + f[j].w * f[j].w); }
        const float r = coef / sqrtf(wave_sum(s) * (1.f / DM) + RMS_EPS); float s2 = 0.f;
#pragma unroll
        for (int j = 0; j < 4; ++j) { h[j] = h[j] + f[j] * gp[j] * r; s2 += (h[j].x * h[j].x + h[j].y * h[j].y) + (h[j].z * h[j].z + h[j].w * h[j].w); }
        if (outf) { GAS f32x4* ho = (GAS f32x4*)(outf + (size_t)m * DM) + lane;
#pragma unroll
            for (int j = 0; j < 4; ++j) ho[64 * j] = h[j]; }
        else { const float r2 = 1.0f / sqrtf(wave_sum(s2) * (1.f / DM) + RMS_EPS);
#pragma unroll
            for (int j = 0; j < 4; ++j) hr[64 * j] = (unsigned long long)pk2(h[j].x, h[j].y) | ((unsigned long long)pk2(h[j].z, h[j].w) << 32);
            if (lane == 0) rs[m] = r2; }
    }
}

__device__ __forceinline__ void gmlp_naive_phase(Frame& F, const float* ln_g, const float* ln_b, const float* w_s, const float* b_s) {
    const bf16* GU = (const bf16*)(F.ws + WS_HB) + 3 * ZSTRIDE; const bf16* GV = GU + ZSTRIDE; const bf16* KB = (const bf16*)(F.ws + WS_HB) + ZSTRIDE;
    bf16* MRG = (bf16*)(F.ws + WS_MRG);
    const int g = F.wave, lane = fresh_lane();
    LAS bf16* vn = (LAS bf16*)(F.lds + RING_OFF + g * 16384);
    LAS float* ssqt = (LAS float*)(F.lds + EXTRA_OFF);
    const float lg = ln_g[g * 64 + lane], lb = ln_b[g * 64 + lane];
    const float* w = w_s + (size_t)g * GCH * GCH; const float* bs = b_s + (size_t)g * GCH;
    for (int unit = blockIdx.x; unit < M / GCH; unit += F.G) {
        const size_t R0 = (size_t)unit * GCH;
        for (int s = 0; s < GCH; ++s) { const float v = bf2f(GV[(R0 + s) * 512 + g * 64 + lane]); const float mean = wave_sum(v) * (1.f / 64.f); const float d = v - mean;
            const float var = wave_sum(d * d) * (1.f / 64.f); const float y = d * (1.0f / sqrtf(var + LN_EPS)) * lg + lb; vn[s * 64 + lane] = (bf16)f2bf(y); }
        LDS_WAIT(); asm volatile("" ::: "memory");
        for (int t = 0; t < GCH; ++t) { float a = 0.f;
            for (int s = 0; s <= t; ++s) a += w[t * GCH + s] * bf2f(vn[s * 64 + lane]);
            a += bs[t];
            const float o = bf2f(GU[(R0 + t) * 512 + g * 64 + lane]) * a; const float ss = wave_sum(o * o);
            MRG[(R0 + t) * DM + AW + g * 64 + lane] = (bf16)f2bf(o); if (lane == 0) ssqt[t * 8 + g] = ss; }
        VM_WAIT(); LDS_WAIT(); __syncthreads();
        for (int t = 0; t < GCH; ++t) { float q = 0.f;
#pragma unroll
            for (int k = 0; k < 8; ++k) q += ssqt[t * 8 + k];
            const float r = 1.0f / sqrtf(q * (1.f / GWD) + RMS_EPS); bf16* p = MRG + (R0 + t) * DM + AW + g * 64 + lane; *p = (bf16)f2bf(bf2f(*p) * r); }
        LDS_WAIT(); __syncthreads();
    }
    float* KM = (float*)(F.ws + WS_KM);
    for (int item = blockIdx.x * NWAVES + F.wave; item < BATCH * NH * NBLK; item += F.G * NWAVES) {
        const int b = item >> 6, h = (item >> 3) & 7, n = item & 7; const bf16* kp = KB + ((size_t)b * SEQ + n * MOBA) * 512 + h * 64 + lane; float s = 0.f;
        for (int j = 0; j < MOBA; ++j) s += bf2f(kp[(size_t)j * 512]);
        KM[item * 64 + lane] = s * (1.f / MOBA);
    }
}


typedef float f32x16 __attribute__((ext_vector_type(16)));
__device__ __forceinline__ void gmlp_mfma_phase(Frame& F, const float* ln_g, const float* ln_b, const bf16* WSB, const float* b_s) {
    const bf16* GU = (const bf16*)(F.ws + WS_HB) + 3 * ZSTRIDE; const bf16* GV = GU + ZSTRIDE;
    bf16* MRG = (bf16*)(F.ws + WS_MRG);
    const int g = F.wave, lane = fresh_lane(), r32 = lane & 31, hi = lane >> 5, dch = lane & 7, srow = lane >> 3;
    LAS unsigned char* vt = F.lds + RING_OFF + g * 16384;
    LAS float* ssqt = (LAS float*)(F.lds + EXTRA_OFF);
    float lg[8], lb[8];
#pragma unroll
    for (int k = 0; k < 8; ++k) { lg[k] = ln_g[g * 64 + 8 * dch + k]; lb[k] = ln_b[g * 64 + 8 * dch + k]; }
    for (int unit = blockIdx.x; unit < M / GCH; unit += F.G) {
        const size_t R0 = (size_t)unit * GCH;
#pragma unroll 4
        for (int i = 0; i < 16; ++i) { const int s = i * 8 + srow; const v4u raw = *(const GAS v4u*)(GV + (R0 + s) * 512 + g * 64 + 8 * dch);
            float v[8]; v[0] = __uint_as_float(raw.x << 16); v[1] = __uint_as_float(raw.x & 0xffff0000u); v[2] = __uint_as_float(raw.y << 16); v[3] = __uint_as_float(raw.y & 0xffff0000u);
            v[4] = __uint_as_float(raw.z << 16); v[5] = __uint_as_float(raw.z & 0xffff0000u); v[6] = __uint_as_float(raw.w << 16); v[7] = __uint_as_float(raw.w & 0xffff0000u);
            float sm = ((v[0] + v[1]) + (v[2] + v[3])) + ((v[4] + v[5]) + (v[6] + v[7])); sm = xadd<1>(sm); sm = xadd<2>(sm); sm = xadd<4>(sm);
            const float mean = sm * (1.f / 64.f); float q = 0.f;
#pragma unroll
            for (int k = 0; k < 8; ++k) { v[k] -= mean; q += v[k] * v[k]; }
            q = xadd<1>(q); q = xadd<2>(q); q = xadd<4>(q);
            const float rstd = 1.0f / sqrtf(q * (1.f / 64.f) + LN_EPS);
#pragma unroll
            for (int k = 0; k < 8; ++k) { const int d = 8 * dch + k; const float y = v[k] * rstd * lg[k] + lb[k];
                *(LAS bf16*)(vt + d * 256 + ((i ^ (d & 15)) << 4) + srow * 2) = (bf16)f2bf(y); } }
        LDS_WAIT(); asm volatile("" ::: "memory");
        f32x16 acc[2][4];
#pragma unroll
        for (int dt = 0; dt < 2; ++dt)
#pragma unroll
            for (int tt = 0; tt < 4; ++tt) acc[dt][tt] = f32x16{};
        const bf16* wrow = WSB + ((size_t)g * GCH + r32) * GCH + 8 * hi;
#pragma unroll
        for (int tt = 0; tt < 4; ++tt) { asm volatile("" ::: "memory");
#pragma unroll
            for (int ks = 0; ks < 2 * tt + 2; ++ks) { const bf16x8 bfrag = *(const GAS bf16x8*)(wrow + (size_t)tt * 32 * GCH + ks * 16); const int c = 2 * ks + hi;
#pragma unroll
                for (int dt = 0; dt < 2; ++dt) { const int d = dt * 32 + r32; const bf16x8 afrag = *(const LAS bf16x8*)(vt + d * 256 + ((c ^ (d & 15)) << 4));
                    acc[dt][tt] = __builtin_amdgcn_mfma_f32_32x32x16_bf16(afrag, bfrag, acc[dt][tt], 0, 0, 0); } } }
#pragma unroll
        for (int tt = 0; tt < 4; ++tt) { const int t = tt * 32 + r32; const float bias = b_s[g * GCH + t]; float ss = 0.f;
#pragma unroll
            for (int dt = 0; dt < 2; ++dt)
#pragma unroll
                for (int q4 = 0; q4 < 4; ++q4) { const int d0 = dt * 32 + 8 * q4 + 4 * hi; const unsigned long long gw = *(const GAS unsigned long long*)(GU + (R0 + t) * 512 + g * 64 + d0);
                    const float u0 = __uint_as_float((unsigned)gw << 16), u1 = __uint_as_float((unsigned)gw & 0xffff0000u), u2 = __uint_as_float((unsigned)(gw >> 32) << 16), u3 = __uint_as_float((unsigned)(gw >> 32) & 0xffff0000u);
                    float o0 = u0 * (acc[dt][tt][4 * q4 + 0] + bias), o1 = u1 * (acc[dt][tt][4 * q4 + 1] + bias), o2 = u2 * (acc[dt][tt][4 * q4 + 2] + bias), o3 = u3 * (acc[dt][tt][4 * q4 + 3] + bias);
                    ss += (o0 * o0 + o1 * o1) + (o2 * o2 + o3 * o3); acc[dt][tt][4 * q4 + 0] = o0; acc[dt][tt][4 * q4 + 1] = o1; acc[dt][tt][4 * q4 + 2] = o2; acc[dt][tt][4 * q4 + 3] = o3; }
            ss = xadd<32>(ss); if (hi == 0) ssqt[t * 8 + g] = ss; }
        LDS_WAIT(); __syncthreads();
#pragma unroll
        for (int tt = 0; tt < 4; ++tt) { const int t = tt * 32 + r32; const f32x4 qa = *(const LAS f32x4*)(ssqt + t * 8), qb = *(const LAS f32x4*)(ssqt + t * 8 + 4);
            const float r = 1.0f / sqrtf((((qa.x + qa.y) + (qa.z + qa.w)) + ((qb.x + qb.y) + (qb.z + qb.w))) * (1.f / GWD) + RMS_EPS);
#pragma unroll
            for (int dt = 0; dt < 2; ++dt)
#pragma unroll
                for (int q4 = 0; q4 < 4; ++q4) { const int d0 = dt * 32 + 8 * q4 + 4 * hi;
                    *(GAS unsigned long long*)(MRG + (R0 + t) * DM + AW + g * 64 + d0) = (unsigned long long)pk2(acc[dt][tt][4 * q4 + 0] * r, acc[dt][tt][4 * q4 + 1] * r) | ((unsigned long long)pk2(acc[dt][tt][4 * q4 + 2] * r, acc[dt][tt][4 * q4 + 3] * r) << 32); } }
        LDS_WAIT(); __syncthreads();
    }
    const bf16* KB = (const bf16*)(F.ws + WS_HB) + ZSTRIDE; float* KM = (float*)(F.ws + WS_KM);
    for (int item = blockIdx.x * NWAVES + F.wave; item < BATCH * NH * NBLK; item += F.G * NWAVES) {
        const int b = item >> 6, h = (item >> 3) & 7, n = item & 7; const bf16* kp = KB + ((size_t)b * SEQ + n * MOBA) * 512 + h * 64 + lane; float s = 0.f;
#pragma unroll 16
        for (int j = 0; j < MOBA; ++j) s += bf2f(kp[(size_t)j * 512]);
        KM[item * 64 + lane] = s * (1.f / MOBA);
    }
}

__device__ __forceinline__ void attn_naive_phase(Frame& F) {
    const bf16* Q = (const bf16*)(F.ws + WS_HB); const bf16* KB = Q + ZSTRIDE; const bf16* VB = KB + ZSTRIDE;
    bf16* MRG = (bf16*)(F.ws + WS_MRG); const float* KM = (const float*)(F.ws + WS_KM); float* SSQ = (float*)(F.ws + WS_SSQ);
    const int lane = fresh_lane(); LAS float* qsh = (LAS float*)(F.lds + RING_OFF + F.wave * 256);
    for (int idx = blockIdx.x * NWAVES + F.wave; idx < BATCH * NH * SEQ; idx += F.G * NWAVES) {
        const int bh = idx & 127, t = idx >> 7, b = bh >> 3, h = bh & 7, own = t >> 8; const size_t row = (size_t)b * SEQ + t;
        const float qd = bf2f(Q[row * 512 + h * 64 + lane]);
        const float sl2 = exp2f(-(float)(h + 1)) * LOG2E;
        float gv[NBLK - 1];
#pragma unroll
        for (int n = 0; n < NBLK - 1; ++n) { const float pr = (n < own) ? qd * KM[((size_t)bh * NBLK + n) * 64 + lane] : 0.f; const float sgate = wave_sum(pr); gv[n] = (n < own) ? sgate : -INFINITY; }
        unsigned mask = 0u;
#pragma unroll
        for (int k = 0; k < 3; ++k) { int best = -1; float bv = -INFINITY;
#pragma unroll
            for (int n = 0; n < NBLK - 1; ++n) if (!((mask >> n) & 1u) && gv[n] > bv) { bv = gv[n]; best = n; }
            if (best >= 0) mask |= 1u << best; }
        mask = (unsigned)__builtin_amdgcn_readfirstlane((int)mask);
        qsh[lane] = qd; LDS_WAIT(); asm volatile("" ::: "memory");
        float mrun = -INFINITY, lrun = 0.f, o = 0.f;
        for (int bi = 0; bi <= NBLK - 1; ++bi) {
            int nb; if (bi == 0) nb = own; else { nb = bi - 1; if (!((mask >> nb) & 1u)) continue; }
            for (int tile = 0; tile < 4; ++tile) {
                const int s0 = nb * MOBA + tile * 64; if (s0 > t) break;
                const int s = s0 + lane; const GAS v4u* kr = (const GAS v4u*)(KB + ((size_t)b * SEQ + s) * 512 + h * 64);
                float dot = 0.f;
#pragma unroll
                for (int c = 0; c < 8; ++c) { const v4u kk = kr[c]; float qs[64]; { const f32x4 qa = *(const LAS f32x4*)(qsh + 8 * c), qb = *(const LAS f32x4*)(qsh + 8 * c + 4); qs[8*c]=qa.x; qs[8*c+1]=qa.y; qs[8*c+2]=qa.z; qs[8*c+3]=qa.w; qs[8*c+4]=qb.x; qs[8*c+5]=qb.y; qs[8*c+6]=qb.z; qs[8*c+7]=qb.w; }
                    dot += qs[8 * c + 0] * __uint_as_float(kk.x << 16) + qs[8 * c + 1] * __uint_as_float(kk.x & 0xffff0000u) + qs[8 * c + 2] * __uint_as_float(kk.y << 16) + qs[8 * c + 3] * __uint_as_float(kk.y & 0xffff0000u)
                         + qs[8 * c + 4] * __uint_as_float(kk.z << 16) + qs[8 * c + 5] * __uint_as_float(kk.z & 0xffff0000u) + qs[8 * c + 6] * __uint_as_float(kk.w << 16) + qs[8 * c + 7] * __uint_as_float(kk.w & 0xffff0000u); }
                float x = dot - sl2 * (float)(t - s); if (s > t) x = -INFINITY;
                const float mnew = fmaxf(mrun, wave_max(x)); const float p = exp2f(x - mnew), f = exp2f(mrun - mnew);
                lrun = lrun * f + wave_sum(p); o *= f; mrun = mnew;
                const bf16* vp = VB + ((size_t)b * SEQ + s0) * 512 + h * 64 + lane;
#pragma unroll 8
                for (int j = 0; j < 64; ++j) { const float pj = __uint_as_float((unsigned)__builtin_amdgcn_readlane((int)__float_as_uint(p), j)); o += pj * bf2f(vp[(size_t)j * 512]); }
            }
        }
        const float res = o / lrun; const float ss = wave_sum(res * res);
        MRG[row * DM + h * 64 + lane] = (bf16)f2bf(res); if (lane == 0) SSQ[row * NH + h] = ss;
    }
}
__device__ __forceinline__ void attn_norm_phase(Frame& F) {
    bf16* MRG = (bf16*)(F.ws + WS_MRG); const float* SSQ = (const float*)(F.ws + WS_SSQ); const int lane = fresh_lane();
    for (int m = blockIdx.x * NWAVES + F.wave; m < M; m += F.G * NWAVES) {
        float q = 0.f;
#pragma unroll
        for (int k = 0; k < NH; ++k) q += SSQ[(size_t)m * NH + k];
        const float r = 1.0f / sqrtf(q * (1.f / AW) + RMS_EPS);
        GAS v4u* p = (GAS v4u*)(MRG + (size_t)m * DM) + lane; v4u w = *p;
        w.x = pk2(__uint_as_float(w.x << 16) * r, __uint_as_float(w.x & 0xffff0000u) * r); w.y = pk2(__uint_as_float(w.y << 16) * r, __uint_as_float(w.y & 0xffff0000u) * r);
        w.z = pk2(__uint_as_float(w.z << 16) * r, __uint_as_float(w.z & 0xffff0000u) * r); w.w = pk2(__uint_as_float(w.w << 16) * r, __uint_as_float(w.w & 0xffff0000u) * r);
        *p = w;
    }
}

#ifndef PG8_SP2
#define PG8_SP2 true
#endif
#ifndef PG8_ALIGN
#define PG8_ALIGN true
#endif
__global__ void __launch_bounds__(NWAVES * 64, 2) mk_fwd(Args args) {
    extern __shared__ __attribute__((aligned(16))) unsigned char lds[];
    Frame F;
    F.lds = (LAS unsigned char*)lds; F.MISC = (volatile LAS unsigned*)(F.lds + MISC_OFF);
    F.tid = threadIdx.x; F.lane = F.tid & 63; F.wave = __builtin_amdgcn_readfirstlane(F.tid >> 6); F.G = gridDim.x;
    F.ws = args.ws; F.out = args.out; F.ctl = (gu32*)(args.ws + WS_CTL);
    for (int u = F.tid; u < (LDS_BYTES - LDSCTL_OFF) / 4; u += NWAVES * 64) ((LAS unsigned*)(F.lds + LDSCTL_OFF))[u] = 0u;
    __syncthreads();
    XcdBarrier bar = xcd_barrier_post((unsigned*)(F.ctl + CW_BAR), F.MISC + 8, F.tid == 0);
#define GRID_BAR() xcd_barrier(bar, F.wave == 0 && hw_lane() == 0)
    using pg8::bf16_t;
    bf16_t* XN = (bf16_t*)(F.ws + WS_XN); float* RS = (float*)(F.ws + WS_RS); bf16_t* HB = (bf16_t*)(F.ws + WS_HB); bf16_t* MRG = (bf16_t*)(F.ws + WS_MRG); bf16_t* FB = (bf16_t*)(F.ws + WS_FB);

    p0_prologue(F, args); GRID_BAR();

        { constexpr int l = 0;

    {
        const bf16_t* wl = (const bf16_t*)(F.ws + WS_W + (size_t)l * WL_STRIDE);
        { pg8::Gemm g{XN, wl + WL_GU1 / 2, M, 2 * DFF, DM}; pg8::StaticOrder S; S.init(M, 2 * DFF, F.G, (int)blockIdx.x); pg8::EpiSwiGLU E{HB, DFF, RS};
          pg8::gemm_phase<pg8::EpiSwiGLU, pg8::StaticOrder, PG8_ALIGN, PG8_SP2>(F.lds + RING_OFF, g, S, E, F.wave); }
        GRID_BAR();
        { pg8::Gemm g{HB, wl + WL_D1 / 2, M, DM, DFF}; pg8::StaticOrder S; S.init(M, DM, F.G, (int)blockIdx.x); pg8::EpiBf16<0> E{FB, DM, nullptr, 0, 0, 1.f};
          pg8::gemm_phase<pg8::EpiBf16<0>, pg8::StaticOrder, PG8_ALIGN, PG8_SP2>(F.lds + RING_OFF, g, S, E, F.wave); }
        GRID_BAR();
        thin_phase(F, (const bf16*)FB, (bf16*)XN, RS, args.in[I_F1POST] + l * DM, 0.5f, nullptr);
        GRID_BAR();
        { pg8::Gemm g{XN, wl + WL_IN / 2, M, INW, DM}; pg8::StaticOrder S; S.init(M, INW, F.G, (int)blockIdx.x); pg8::EpiInProj E{HB, ZSTRIDE, QSCALE, RS};
          pg8::gemm_phase<pg8::EpiInProj, pg8::StaticOrder, PG8_ALIGN, PG8_SP2>(F.lds + RING_OFF, g, S, E, F.wave); }
        GRID_BAR();
        gmlp_mfma_phase(F, args.in[I_LNG] + l * GWD, args.in[I_LNB] + l * GWD, (const bf16*)(F.ws + WS_WSB) + (size_t)l * NGRP * GCH * GCH, args.in[I_BS] + (size_t)l * NGRP * GCH);
        GRID_BAR();
        { const attn_body::AttnTensors AT{(const attn_body::bf16*)(F.ws + WS_HB), (const attn_body::bf16*)(F.ws + WS_HB) + ZSTRIDE, (const attn_body::bf16*)(F.ws + WS_HB) + 2 * ZSTRIDE, (attn_body::bf16*)(F.ws + WS_MRG), (float*)(F.ws + WS_SSQ), (const float*)(F.ws + WS_KM)};
          const attn_body::MobaOrder S((int)F.G, (int)blockIdx.x); attn_body::attn_phase<attn_body::MobaOrder>((char*)lds + RING_OFF, AT, S, F.wave); }
        GRID_BAR();
        attn_norm_phase(F);
        GRID_BAR();
        { pg8::Gemm g{MRG, wl + WL_OUT / 2, M, DM, DM}; pg8::StaticOrder S; S.init(M, DM, F.G, (int)blockIdx.x); pg8::EpiBf16<0> E{FB, DM, nullptr, 0, 0, 1.f};
          pg8::gemm_phase<pg8::EpiBf16<0>, pg8::StaticOrder, PG8_ALIGN, PG8_SP2>(F.lds + RING_OFF, g, S, E, F.wave); }
        GRID_BAR();
        thin_phase(F, (const bf16*)FB, (bf16*)XN, RS, args.in[I_MIXPOST] + l * DM, 1.0f, nullptr);
        GRID_BAR();
        { pg8::Gemm g{XN, wl + WL_GU2 / 2, M, 2 * DFF, DM}; pg8::StaticOrder S; S.init(M, 2 * DFF, F.G, (int)blockIdx.x); pg8::EpiSwiGLU E{HB, DFF, RS};
          pg8::gemm_phase<pg8::EpiSwiGLU, pg8::StaticOrder, PG8_ALIGN, PG8_SP2>(F.lds + RING_OFF, g, S, E, F.wave); }
        GRID_BAR();
        { pg8::Gemm g{HB, wl + WL_D2 / 2, M, DM, DFF}; pg8::StaticOrder S; S.init(M, DM, F.G, (int)blockIdx.x); pg8::EpiBf16<0> E{FB, DM, nullptr, 0, 0, 1.f};
          pg8::gemm_phase<pg8::EpiBf16<0>, pg8::StaticOrder, PG8_ALIGN, PG8_SP2>(F.lds + RING_OFF, g, S, E, F.wave); }
        GRID_BAR();
        { pg8::Gemm g{(const bf16_t*)(F.ws + WS_PBF) + (size_t)l * M * PLE, wl + WL_PP / 2, M, DM, PLE}; pg8::StaticOrder S; S.init(M, DM, F.G, (int)blockIdx.x); pg8::EpiBf16<0> E{HB, DM, nullptr, 0, 0, 1.f};
          pg8::gemm_phase<pg8::EpiBf16<0>, pg8::StaticOrder, PG8_ALIGN, PG8_SP2>(F.lds + RING_OFF, g, S, E, F.wave); }
        thin_phase(F, (const bf16*)FB, (bf16*)XN, RS, args.in[I_F2POST] + l * DM, 0.5f, nullptr);
        GRID_BAR();
        { pg8::Gemm g{XN, wl + WL_PG / 2, M, DM, DM}; pg8::StaticOrder S; S.init(M, DM, F.G, (int)blockIdx.x); pg8::EpiPleGate E{FB, HB, DM, RS};
          pg8::gemm_phase<pg8::EpiPleGate, pg8::StaticOrder, PG8_ALIGN, PG8_SP2>(F.lds + RING_OFF, g, S, E, F.wave); }
        GRID_BAR();
        thin_phase(F, (const bf16*)FB, (bf16*)XN, RS, args.in[I_PLEPOST] + l * DM, 1.0f, l + 1 < DEPTH ? (float*)nullptr : F.out);
        if (l + 1 < DEPTH) GRID_BAR();
    }
        }
    { constexpr int l = 1;

    {
        const bf16_t* wl = (const bf16_t*)(F.ws + WS_W + (size_t)l * WL_STRIDE);
        { pg8::Gemm g{XN, wl + WL_GU1 / 2, M, 2 * DFF, DM}; pg8::StaticOrder S; S.init(M, 2 * DFF, F.G, (int)blockIdx.x); pg8::EpiSwiGLU E{HB, DFF, RS};
          pg8::gemm_phase<pg8::EpiSwiGLU, pg8::StaticOrder, PG8_ALIGN, PG8_SP2>(F.lds + RING_OFF, g, S, E, F.wave); }
        GRID_BAR();
        { pg8::Gemm g{HB, wl + WL_D1 / 2, M, DM, DFF}; pg8::StaticOrder S; S.init(M, DM, F.G, (int)blockIdx.x); pg8::EpiBf16<0> E{FB, DM, nullptr, 0, 0, 1.f};
          pg8::gemm_phase<pg8::EpiBf16<0>, pg8::StaticOrder, PG8_ALIGN, PG8_SP2>(F.lds + RING_OFF, g, S, E, F.wave); }
        GRID_BAR();
        thin_phase(F, (const bf16*)FB, (bf16*)XN, RS, args.in[I_F1POST] + l * DM, 0.5f, nullptr);
        GRID_BAR();
        { pg8::Gemm g{XN, wl + WL_IN / 2, M, INW, DM}; pg8::StaticOrder S; S.init(M, INW, F.G, (int)blockIdx.x); pg8::EpiInProj E{HB, ZSTRIDE, QSCALE, RS};
          pg8::gemm_phase<pg8::EpiInProj, pg8::StaticOrder, PG8_ALIGN, PG8_SP2>(F.lds + RING_OFF, g, S, E, F.wave); }
        GRID_BAR();
        gmlp_mfma_phase(F, args.in[I_LNG] + l * GWD, args.in[I_LNB] + l * GWD, (const bf16*)(F.ws + WS_WSB) + (size_t)l * NGRP * GCH * GCH, args.in[I_BS] + (size_t)l * NGRP * GCH);
        GRID_BAR();
        { const attn_body::AttnTensors AT{(const attn_body::bf16*)(F.ws + WS_HB), (const attn_body::bf16*)(F.ws + WS_HB) + ZSTRIDE, (const attn_body::bf16*)(F.ws + WS_HB) + 2 * ZSTRIDE, (attn_body::bf16*)(F.ws + WS_MRG), (float*)(F.ws + WS_SSQ), (const float*)(F.ws + WS_KM)};
          const attn_body::MobaOrder S((int)F.G, (int)blockIdx.x); attn_body::attn_phase<attn_body::MobaOrder>((char*)lds + RING_OFF, AT, S, F.wave); }
        GRID_BAR();
        attn_norm_phase(F);
        GRID_BAR();
        { pg8::Gemm g{MRG, wl + WL_OUT / 2, M, DM, DM}; pg8::StaticOrder S; S.init(M, DM, F.G, (int)blockIdx.x); pg8::EpiBf16<0> E{FB, DM, nullptr, 0, 0, 1.f};
          pg8::gemm_phase<pg8::EpiBf16<0>, pg8::StaticOrder, PG8_ALIGN, PG8_SP2>(F.lds + RING_OFF, g, S, E, F.wave); }
        GRID_BAR();
        thin_phase(F, (const bf16*)FB, (bf16*)XN, RS, args.in[I_MIXPOST] + l * DM, 1.0f, nullptr);
        GRID_BAR();
        { pg8::Gemm g{XN, wl + WL_GU2 / 2, M, 2 * DFF, DM}; pg8::StaticOrder S; S.init(M, 2 * DFF, F.G, (int)blockIdx.x); pg8::EpiSwiGLU E{HB, DFF, RS};
          pg8::gemm_phase<pg8::EpiSwiGLU, pg8::StaticOrder, PG8_ALIGN, PG8_SP2>(F.lds + RING_OFF, g, S, E, F.wave); }
        GRID_BAR();
        { pg8::Gemm g{HB, wl + WL_D2 / 2, M, DM, DFF}; pg8::StaticOrder S; S.init(M, DM, F.G, (int)blockIdx.x); pg8::EpiBf16<0> E{FB, DM, nullptr, 0, 0, 1.f};
          pg8::gemm_phase<pg8::EpiBf16<0>, pg8::StaticOrder, PG8_ALIGN, PG8_SP2>(F.lds + RING_OFF, g, S, E, F.wave); }
        GRID_BAR();
        { pg8::Gemm g{(const bf16_t*)(F.ws + WS_PBF) + (size_t)l * M * PLE, wl + WL_PP / 2, M, DM, PLE}; pg8::StaticOrder S; S.init(M, DM, F.G, (int)blockIdx.x); pg8::EpiBf16<0> E{HB, DM, nullptr, 0, 0, 1.f};
          pg8::gemm_phase<pg8::EpiBf16<0>, pg8::StaticOrder, PG8_ALIGN, PG8_SP2>(F.lds + RING_OFF, g, S, E, F.wave); }
        thin_phase(F, (const bf16*)FB, (bf16*)XN, RS, args.in[I_F2POST] + l * DM, 0.5f, nullptr);
        GRID_BAR();
        { pg8::Gemm g{XN, wl + WL_PG / 2, M, DM, DM}; pg8::StaticOrder S; S.init(M, DM, F.G, (int)blockIdx.x); pg8::EpiPleGate E{FB, HB, DM, RS};
          pg8::gemm_phase<pg8::EpiPleGate, pg8::StaticOrder, PG8_ALIGN, PG8_SP2>(F.lds + RING_OFF, g, S, E, F.wave); }
        GRID_BAR();
        thin_phase(F, (const bf16*)FB, (bf16*)XN, RS, args.in[I_PLEPOST] + l * DM, 1.0f, l + 1 < DEPTH ? (float*)nullptr : F.out);
        if (l + 1 < DEPTH) GRID_BAR();
    }
        }

}

extern "C" void kernel_launch(void* const* d_in, const int* in_sizes, int n_in, void* d_out, int out_size, void* d_ws, size_t ws_size, hipStream_t stream) {
    static int grid = 0;
    if (grid == 0) {
        if (n_in != 26 || in_sizes[0] != M * DM || out_size != M * DM || ws_size < WS_END) { fprintf(stderr, "kernel_launch: unexpected shapes (n_in %d, in0 %d, out %d, ws %zu)\n", n_in, n_in > 0 ? in_sizes[0] : -1, out_size, ws_size); grid = -1; return; }
        int dev = 0, cus = 0, per_cu = 0;
        if (hipGetDevice(&dev) != hipSuccess || hipDeviceGetAttribute(&cus, hipDeviceAttributeMultiprocessorCount, dev) != hipSuccess) { grid = -1; return; }
        if (hipFuncSetAttribute((const void*)mk_fwd, hipFuncAttributeMaxDynamicSharedMemorySize, LDS_BYTES) != hipSuccess) { fprintf(stderr, "kernel_launch: hipFuncSetAttribute failed\n"); grid = -1; return; }
        if (hipOccupancyMaxActiveBlocksPerMultiprocessor(&per_cu, (const void*)mk_fwd, NWAVES * 64, LDS_BYTES) != hipSuccess || per_cu < 1) { fprintf(stderr, "kernel_launch: occupancy query reports %d\n", per_cu); }
        (void)hipGetLastError();
        grid = cus;
    }
    if (grid < 0) return;
    if (hipMemsetAsync((char*)d_ws + WS_CTL, 0, CTL_ZERO_BYTES, stream) != hipSuccess) return;
    Args a{};
    for (int i = 0; i < 26; ++i) a.in[i] = (const float*)d_in[i];
    a.out = (float*)d_out; a.ws = (unsigned char*)d_ws;
    hipLaunchKernelGGL(mk_fwd, dim3(grid), dim3(NWAVES * 64), LDS_BYTES, stream, a);
}
```
